# Optimizing an MI355X kernel written in HIP

```python
import math
import jax, jax.numpy as jnp
from jax import lax
import numpy as np

D_MODEL = 1024
BATCH = 8
SEQ = 2048
DEPTH = 4

CHUNK = 64
Q_BLOCK = 128
N_MEM = 256
EPS = 1e-6
NEG_INF = -1e30
ROPE_THETA = 500000.0
RET_THETA = 10000.0

RET_HEADS = 4
RET_DK = 64
RET_DV = 128
MLA_HEADS = 8
MLA_Q_RANK = 256
MLA_KV_RANK = 128
MLA_NOPE = 64
MLA_ROPE = 32
MLA_DV = 64
DIFF_HEADS = 4
DIFF_HD = 64
DIFF_ROT = DIFF_HD // 4
N_BRANCH = 3
BRANCH_WIDTH = 512
CROSS_HEADS = 4
CROSS_HD = D_MODEL // CROSS_HEADS
D_FF = 2816

IN_SPLITS = (
    RET_HEADS * RET_DK,
    RET_HEADS * RET_DK,
    RET_HEADS * RET_DV,
    RET_HEADS * RET_DV,
    MLA_Q_RANK,
    MLA_KV_RANK + MLA_ROPE,
    2 * DIFF_HEADS * DIFF_HD,
    2 * DIFF_HEADS * DIFF_HD,
    2 * DIFF_HEADS * DIFF_HD,
    N_BRANCH * D_MODEL,
)
IN_WIDTH = sum(IN_SPLITS)

kernel_name = 'hybrid_streaming_encoder_block'


def rms_norm(x, gain=None):
    xf = x.astype(jnp.float32)
    y = xf * lax.rsqrt(jnp.mean(xf * xf, axis=-1, keepdims=True) + EPS)
    if gain is not None:
        y = y * gain.astype(jnp.float32)
    return y.astype(x.dtype)


def rope_angles(positions, dim, theta):
    inv = 1.0 / (theta ** (jnp.arange(0, dim, 2, dtype=jnp.float32) / dim))
    ang = positions.astype(jnp.float32)[..., None] * inv
    return jnp.cos(ang), jnp.sin(ang)


def apply_rope(x, cos, sin):
    half = x.shape[-1] // 2
    x1, x2 = x[..., :half], x[..., half:]
    c = cos.astype(x.dtype)
    s = sin.astype(x.dtype)
    return jnp.concatenate([x1 * c - x2 * s, x2 * c + x1 * s], axis=-1)


def partial_rope(x, cos, sin, rot):
    return jnp.concatenate([apply_rope(x[..., :rot], cos, sin), x[..., rot:]], axis=-1)


def to_blocks(t):
    b, s = t.shape[:2]
    return jnp.moveaxis(t.reshape((b, s // Q_BLOCK, Q_BLOCK) + t.shape[2:]), 1, 0)


def from_blocks(t):
    t = jnp.moveaxis(t, 0, 1)
    return t.reshape((t.shape[0], t.shape[1] * t.shape[2]) + t.shape[3:])


def chunk_causal_mask(block_idx, seq):
    q_pos = block_idx * Q_BLOCK + jnp.arange(Q_BLOCK)
    k_pos = jnp.arange(seq)
    return (k_pos[None, :] // CHUNK) <= (q_pos[:, None] // CHUNK)


def masked_softmax(scores, mask):
    s = jnp.where(mask, scores.astype(jnp.float32), NEG_INF)
    return jax.nn.softmax(s, axis=-1)


def swiglu(h, w13, w2):
    gate, up = jnp.split(h @ w13, 2, axis=-1)
    return (jax.nn.silu(gate) * up) @ w2


def retention(q, k, v, g):
    b, s, h, dk = q.shape
    nc = s // CHUNK
    dt = q.dtype
    q = q * (dk ** -0.5)
    log_gamma = jnp.log(1.0 - 2.0 ** (-5.0 - jnp.arange(h, dtype=jnp.float32)))
    idx = jnp.arange(CHUNK, dtype=jnp.float32)
    intra_decay = jnp.exp(log_gamma[:, None, None] * jnp.abs(idx[:, None] - idx[None, :]))
    q_decay = jnp.exp(log_gamma[None, :] * (idx[:, None] + 1.0))
    k_decay = jnp.exp(log_gamma[None, :] * (CHUNK - 1.0 - idx[:, None]))
    chunk_decay = jnp.exp(log_gamma * CHUNK).astype(dt)
    qc = q.reshape(b, nc, CHUNK, h, dk)
    kc = k.reshape(b, nc, CHUNK, h, dk)
    vc = v.reshape(b, nc, CHUNK, h, -1)
    scores = jnp.einsum('bcnhd,bcmhd->bchnm', qc, kc) * intra_decay.astype(dt)
    o_intra = jnp.einsum('bchnm,bcmhe->bcnhe', scores, vc)
    kv = jnp.einsum('bcmhd,bcmhe->bchde', kc * k_decay.astype(dt)[:, :, None], vc)

    def step(state, kv_c):
        return state * chunk_decay[None, :, None, None] + kv_c, state

    _, s_prev = lax.scan(step, jnp.zeros_like(kv[:, 0]), jnp.moveaxis(kv, 1, 0))
    s_prev = jnp.moveaxis(s_prev, 0, 1)
    o_cross = jnp.einsum('bcnhd,bchde->bcnhe', qc * q_decay.astype(dt)[:, :, None], s_prev)
    o = rms_norm(o_intra + o_cross).reshape(b, s, -1)
    return jax.nn.silu(g) * o


def latent_attention(c_q_raw, kv_a, q_norm, kv_norm, wq_b, wkv_b, cos, sin):
    b, s, _ = c_q_raw.shape
    q = (rms_norm(c_q_raw, q_norm) @ wq_b).reshape(b, s, MLA_HEADS, MLA_NOPE + MLA_ROPE)
    q_nope = q[..., :MLA_NOPE]
    q_rope = apply_rope(q[..., MLA_NOPE:], cos[:, :, None], sin[:, :, None])
    c_kv, k_rope = kv_a[..., :MLA_KV_RANK], kv_a[..., MLA_KV_RANK:]
    k_rope = apply_rope(k_rope, cos, sin)
    kv = (rms_norm(c_kv, kv_norm) @ wkv_b).reshape(b, s, MLA_HEADS, MLA_NOPE + MLA_DV)
    k_nope, v = kv[..., :MLA_NOPE], kv[..., MLA_NOPE:]
    scale = (MLA_NOPE + MLA_ROPE) ** -0.5

    def block(args):
        qn, qr, i = args
        sc = (jnp.einsum('bqhd,bkhd->bhqk', qn, k_nope)
              + jnp.einsum('bqhd,bkd->bhqk', qr, k_rope)) * scale
        p = masked_softmax(sc, chunk_causal_mask(i, s))
        return jnp.einsum('bhqk,bkhe->bqhe', p.astype(v.dtype), v)

    o = lax.map(block, (to_blocks(q_nope), to_blocks(q_rope), jnp.arange(s // Q_BLOCK)))
    return from_blocks(o).reshape(b, s, -1)


def diff_attention(q, k, v, lam_params, lambda_init, cos, sin):
    b, s, _ = q.shape
    q = q.reshape(b, s, DIFF_HEADS, 2, DIFF_HD)
    k = k.reshape(b, s, DIFF_HEADS, 2, DIFF_HD)
    v = v.reshape(b, s, DIFF_HEADS, 2 * DIFF_HD)
    c, sn = cos[:, :, None, None], sin[:, :, None, None]
    q = partial_rope(q, c, sn, DIFF_ROT)
    k = partial_rope(k, c, sn, DIFF_ROT)
    lp = lam_params.astype(jnp.float32)
    lam = jnp.exp(jnp.sum(lp[0] * lp[1])) - jnp.exp(jnp.sum(lp[2] * lp[3])) + lambda_init
    scale = DIFF_HD ** -0.5

    def block(args):
        qb, i = args
        sc = jnp.einsum('bqhjd,bkhjd->bhjqk', qb, k) * scale
        p = masked_softmax(sc, chunk_causal_mask(i, s))
        w = p[:, :, 0] - lam * p[:, :, 1]
        return jnp.einsum('bhqk,bkhe->bqhe', w.astype(v.dtype), v)

    o = from_blocks(lax.map(block, (to_blocks(q), jnp.arange(s // Q_BLOCK))))
    o = rms_norm(o) * (1.0 - lambda_init)
    return o.reshape(b, s, -1)


def cross_attention(h, mem_n, wq, wkv, wo):
    b, s, _ = h.shape
    q = (h @ wq).reshape(b, s, CROSS_HEADS, CROSS_HD)
    kv = (mem_n @ wkv).reshape(b, mem_n.shape[1], 2, CROSS_HEADS, CROSS_HD)
    k, v = kv[:, :, 0], kv[:, :, 1]
    sc = jnp.einsum('bqhd,bkhd->bhqk', q, k) * (CROSS_HD ** -0.5)
    p = jax.nn.softmax(sc.astype(jnp.float32), axis=-1).astype(v.dtype)
    o = jnp.einsum('bhqk,bkhe->bqhe', p, v).reshape(b, s, D_MODEL)
    return o @ wo


def token_mixing(h, w_in, mla_q_norm, mla_kv_norm, mla_wq_b, mla_wkv_b, diff_lambda,
                 w_branch, w_out, lambda_init, ret_rope, mla_rope, diff_rope):
    b, s, _ = h.shape
    split_points = [int(i) for i in np.cumsum(IN_SPLITS)[:-1]]
    (ret_q, ret_k, ret_v, ret_g, mla_qa, mla_kva,
     d_q, d_k, d_v, gate_logits) = jnp.split(h @ w_in, split_points, axis=-1)
    rc, rs = ret_rope[0][:, :, None], ret_rope[1][:, :, None]
    y_ret = retention(apply_rope(ret_q.reshape(b, s, RET_HEADS, RET_DK), rc, rs),
                      apply_rope(ret_k.reshape(b, s, RET_HEADS, RET_DK), rc, rs),
                      ret_v.reshape(b, s, RET_HEADS, RET_DV), ret_g)
    y_mla = latent_attention(mla_qa, mla_kva, mla_q_norm, mla_kv_norm, mla_wq_b, mla_wkv_b,
                             mla_rope[0], mla_rope[1])
    y_diff = diff_attention(d_q, d_k, d_v, diff_lambda, lambda_init, diff_rope[0], diff_rope[1])
    branches = jnp.stack([y_ret, y_mla, y_diff], axis=2)
    proj = jnp.einsum('bsnw,nwd->bsnd', branches, w_branch)
    gates = jax.nn.sigmoid(gate_logits.reshape(b, s, N_BRANCH, D_MODEL))
    return jnp.sum(gates * proj, axis=2) @ w_out


def setup_inputs(seed: int = 0) -> dict:
    key = jax.random.key(seed)
    ks = jax.random.split(key, 24)
    f32 = jnp.float32

    def dense(k, shape, fan_in):
        return jax.random.normal(k, shape, f32) * (fan_in ** -0.5)

    def gains(k, shape):
        return 1.0 + 0.05 * jax.random.normal(k, shape, f32)

    offsets = jax.random.randint(ks[2], (BATCH, 1), 0, 64) * CHUNK
    positions = (offsets + jnp.arange(SEQ)[None, :]).astype(jnp.int32)
    return {
        'x': jax.random.normal(ks[0], (BATCH, SEQ, D_MODEL), f32),
        'mem': jax.random.normal(ks[1], (BATCH, N_MEM, D_MODEL), f32),
        'positions': positions,
        'ffn1_norms': gains(ks[3], (DEPTH, 2, D_MODEL)),
        'ffn1_w13': dense(ks[4], (DEPTH, D_MODEL, 2 * D_FF), D_MODEL),
        'ffn1_w2': dense(ks[5], (DEPTH, D_FF, D_MODEL), D_FF),
        'mix_norms': gains(ks[6], (DEPTH, 2, D_MODEL)),
        'w_in': dense(ks[7], (DEPTH, D_MODEL, IN_WIDTH), D_MODEL),
        'mla_q_norm': gains(ks[8], (DEPTH, MLA_Q_RANK)),
        'mla_kv_norm': gains(ks[9], (DEPTH, MLA_KV_RANK)),
        'mla_wq_b': dense(ks[10], (DEPTH, MLA_Q_RANK, MLA_HEADS * (MLA_NOPE + MLA_ROPE)), MLA_Q_RANK),
        'mla_wkv_b': dense(ks[11], (DEPTH, MLA_KV_RANK, MLA_HEADS * (MLA_NOPE + MLA_DV)), MLA_KV_RANK),
        'diff_lambda': 0.1 * jax.random.normal(ks[12], (DEPTH, 4, DIFF_HD), f32),
        'w_branch': dense(ks[13], (DEPTH, N_BRANCH, BRANCH_WIDTH, D_MODEL), BRANCH_WIDTH),
        'w_out': dense(ks[14], (DEPTH, D_MODEL, D_MODEL), D_MODEL),
        'cross_norms': gains(ks[15], (DEPTH, 3, D_MODEL)),
        'cross_wq': dense(ks[16], (DEPTH, D_MODEL, D_MODEL), D_MODEL),
        'cross_wkv': dense(ks[17], (DEPTH, D_MODEL, 2 * D_MODEL), D_MODEL),
        'cross_wo': dense(ks[18], (DEPTH, D_MODEL, D_MODEL), D_MODEL),
        'ffn2_norms': gains(ks[19], (DEPTH, 2, D_MODEL)),
        'ffn2_w13': dense(ks[20], (DEPTH, D_MODEL, 2 * D_FF), D_MODEL),
        'ffn2_w2': dense(ks[21], (DEPTH, D_FF, D_MODEL), D_FF),
    }


def reference(x, mem, positions, ffn1_norms, ffn1_w13, ffn1_w2, mix_norms, w_in,
              mla_q_norm, mla_kv_norm, mla_wq_b, mla_wkv_b, diff_lambda, w_branch, w_out,
              cross_norms, cross_wq, cross_wkv, cross_wo, ffn2_norms, ffn2_w13, ffn2_w2):
    ret_rope = rope_angles(positions, RET_DK, RET_THETA)
    mla_rope = rope_angles(positions, MLA_ROPE, ROPE_THETA)
    diff_rope = rope_angles(positions, DIFF_ROT, ROPE_THETA)
    for l in range(DEPTH):
        lambda_init = 0.8 - 0.6 * math.exp(-0.3 * l)
        h = rms_norm(x, ffn1_norms[l, 0])
        x = x + 0.5 * rms_norm(swiglu(h, ffn1_w13[l], ffn1_w2[l]), ffn1_norms[l, 1])
        h = rms_norm(x, mix_norms[l, 0])
        y = token_mixing(h, w_in[l], mla_q_norm[l], mla_kv_norm[l], mla_wq_b[l], mla_wkv_b[l],
                         diff_lambda[l], w_branch[l], w_out[l], lambda_init,
                         ret_rope, mla_rope, diff_rope)
        x = x + rms_norm(y, mix_norms[l, 1])
        h = rms_norm(x, cross_norms[l, 0])
        m = rms_norm(mem, cross_norms[l, 2])
        x = x + rms_norm(cross_attention(h, m, cross_wq[l], cross_wkv[l], cross_wo[l]), cross_norms[l, 1])
        h = rms_norm(x, ffn2_norms[l, 0])
        x = x + 0.5 * rms_norm(swiglu(h, ffn2_w13[l], ffn2_w2[l]), ffn2_norms[l, 1])
    return x
```

```cpp
#include <hip/hip_runtime.h>
#include <hip/hip_cooperative_groups.h>
#include <cstdio>
#include <cstdint>
#include <cstring>
#include <cmath>
namespace cg = cooperative_groups;
namespace pg8 {
#define PG8_LAS __attribute__((address_space(3)))
typedef unsigned short bf16_t;
typedef short bf16x8 __attribute__((ext_vector_type(8)));
typedef float f32x4 __attribute__((ext_vector_type(4)));
typedef unsigned u32x4 __attribute__((ext_vector_type(4)));
constexpr int BM = 256, BK = 64, HALF = 128, HTB = HALF * BK * 2  , STAGE_BYTES = 8 * HTB, NXCD = 8, WGM = 8;

__host__ __device__ __forceinline__ int lds_byte(int r, int c) { const int st = (r >> 4) * 2 + (c >> 5), rr = r & 15, cc = c & 31, ob = rr * 64 + cc * 2; return st * 1024 + (ob ^ (((ob >> 9) & 1) << 5)); }
__host__ __device__ __forceinline__ void stage_rc(int b, int& R, int& C) { const int st = b / 1024, sb = b % 1024, swz = sb ^ (((sb >> 9) & 1) << 5); R = (st >> 1) * 16 + swz / 64; C = (st & 1) * 32 + (swz % 64) / 2; }
__host__ __device__ __forceinline__ int perm32(int rho) { const int n = rho >> 4, i = rho & 15; return 8 * (i >> 2) + 4 * n + (i & 3); }

struct Unit { int pm, pn; };
struct Gemm { const bf16_t* A; const bf16_t* Bt; int M, N, K; };

struct StaticOrder {
    int nM, nN, nwg, G, c;
    __host__ __device__ void init(int M, int N, int G_, int c_) { nM = M / BM; nN = N / BM; nwg = nM * nN; G = G_; c = c_; }
    __host__ __device__ bool next(int i, Unit& u) const {
        const long L = (long)i * G + c; if (L >= nwg) return false;
        int wgid = (int)L; { const int q = nwg / NXCD, r = nwg % NXCD, xcd = wgid % NXCD, off = wgid / NXCD; wgid = (xcd < r ? xcd * (q + 1) : r * (q + 1) + (xcd - r) * q) + off; }
        const int nig = WGM * nN, gid = wgid / nig, fm = gid * WGM, gsz = (nM - fm) < WGM ? (nM - fm) : WGM;
        u.pm = fm + ((wgid % nig) % gsz); u.pn = (wgid % nig) / gsz; return true;
    }
    __device__ __forceinline__ void a_ready(const Unit&) const {}
    __device__ __forceinline__ void done(const Unit&) const {}
};
typedef float f32x2_cv __attribute__((ext_vector_type(2))); typedef __bf16 bf16x2_cv __attribute__((ext_vector_type(2)));
__device__ __forceinline__ unsigned cvt_pk_bf16(float lo, float hi) { f32x2_cv v = {lo, hi}; bf16x2_cv b = __builtin_convertvector(v, bf16x2_cv); return __builtin_bit_cast(unsigned, b); }
typedef float f32x2 __attribute__((ext_vector_type(2)));

typedef unsigned u32x2 __attribute__((ext_vector_type(2)));
__device__ __forceinline__ float sigmoidf_(float x) { return 1.0f / (1.0f + __expf(-x)); }
__device__ __forceinline__ float bf_lo(unsigned w) { return __uint_as_float(w << 16); }
__device__ __forceinline__ float bf_hi(unsigned w) { return __uint_as_float(w & 0xffff0000u); }
template <int MODE> struct EpiX {
    static constexpr bool PERM = true, AFTER_DRAIN = false;
    void* O; const void* aux; int ldc;
    __device__ __forceinline__ void operator()(const f32x4 (&acc)[2][2][4][2], const Unit& u, int wr, int wc, int fr, int fq) const {
        int pm = u.pm, pn = u.pn, bsel = 0;
        if (MODE == 4) { bsel = pm >> 6; pm &= 63; pn &= 3; }
        if (MODE == 5) { bsel = pm >> 3; pm &= 7; pn &= 7; }
        const int row0 = pm * BM + wr * 64 + fr, col0 = pn * BM + wc * 32 + 8 * fq;
#pragma unroll
        for (int ai = 0; ai < 2; ++ai)
#pragma unroll
            for (int m = 0; m < 4; ++m) {
                const size_t row = (size_t)(row0 + ai * HALF + m * 16);
#pragma unroll
                for (int bj = 0; bj < 2; ++bj) {
                    const f32x4 v0 = acc[ai][bj][m][0], v1 = acc[ai][bj][m][1];
                    const int col = col0 + bj * HALF;
                    if (MODE == 0) {
                        u32x4 w; w.x = cvt_pk_bf16(v0[0], v0[1]); w.y = cvt_pk_bf16(v0[2], v0[3]); w.z = cvt_pk_bf16(v1[0], v1[1]); w.w = cvt_pk_bf16(v1[2], v1[3]);
                        *(u32x4*)((bf16_t*)O + row * ldc + col) = w;
                    } else if (MODE == 1) {
                        float r0 = v0[0] * sigmoidf_(v0[0]) * v1[0], r1 = v0[1] * sigmoidf_(v0[1]) * v1[1], r2 = v0[2] * sigmoidf_(v0[2]) * v1[2], r3 = v0[3] * sigmoidf_(v0[3]) * v1[3];
                        u32x2 w; w.x = cvt_pk_bf16(r0, r1); w.y = cvt_pk_bf16(r2, r3);
                        *(u32x2*)((bf16_t*)O + row * ldc + (col >> 1)) = w;
                    } else if (MODE == 2) {
                        float* p = (float*)O + row * ldc + col; *(f32x4*)p = v0; *(f32x4*)(p + 4) = v1;
                    } else if (MODE == 3) {
                        u32x4 w; w.x = cvt_pk_bf16(sigmoidf_(v0[0]), sigmoidf_(v0[1])); w.y = cvt_pk_bf16(sigmoidf_(v0[2]), sigmoidf_(v0[3]));
                        w.z = cvt_pk_bf16(sigmoidf_(v1[0]), sigmoidf_(v1[1])); w.w = cvt_pk_bf16(sigmoidf_(v1[2]), sigmoidf_(v1[3]));
                        *(u32x4*)((bf16_t*)O + row * ldc + col) = w;
                    } else if (MODE == 4) {
                        const u32x4 gw = *(const u32x4*)((const bf16_t*)aux + row * 3072 + bsel * 1024 + col);
                        bf16_t* zp = (bf16_t*)O + row * 1024 + col;
                        float z0 = 0.f, z1 = 0.f, z2 = 0.f, z3 = 0.f, z4 = 0.f, z5 = 0.f, z6 = 0.f, z7 = 0.f;
                        if (bsel != 0) { const u32x4 zw = *(const u32x4*)zp; z0 = bf_lo(zw.x); z1 = bf_hi(zw.x); z2 = bf_lo(zw.y); z3 = bf_hi(zw.y); z4 = bf_lo(zw.z); z5 = bf_hi(zw.z); z6 = bf_lo(zw.w); z7 = bf_hi(zw.w); }
                        z0 += bf_lo(gw.x) * v0[0]; z1 += bf_hi(gw.x) * v0[1]; z2 += bf_lo(gw.y) * v0[2]; z3 += bf_hi(gw.y) * v0[3];
                        z4 += bf_lo(gw.z) * v1[0]; z5 += bf_hi(gw.z) * v1[1]; z6 += bf_lo(gw.w) * v1[2]; z7 += bf_hi(gw.w) * v1[3];
                        u32x4 w; w.x = cvt_pk_bf16(z0, z1); w.y = cvt_pk_bf16(z2, z3); w.z = cvt_pk_bf16(z4, z5); w.w = cvt_pk_bf16(z6, z7);
                        *(u32x4*)zp = w;
                    } else {
                        if (pn < 4) {
                            u32x4 w; w.x = cvt_pk_bf16(v0[0], v0[1]); w.y = cvt_pk_bf16(v0[2], v0[3]); w.z = cvt_pk_bf16(v1[0], v1[1]); w.w = cvt_pk_bf16(v1[2], v1[3]);
                            *(u32x4*)((bf16_t*)O + (size_t)bsel * 2048 * 1024 + row * 1024 + col) = w;
                        } else {
                            const int key = (int)row & 255, d0 = col & 255, h = pn - 4;
                            bf16_t* vt = (bf16_t*)aux + (size_t)bsel * 2048 * 1024 + ((size_t)((pm * 4 + h) * 256 + d0)) * 256 + key;
                            const unsigned w0 = cvt_pk_bf16(v0[0], v0[1]), w1 = cvt_pk_bf16(v0[2], v0[3]), w2 = cvt_pk_bf16(v1[0], v1[1]), w3 = cvt_pk_bf16(v1[2], v1[3]);
                            vt[0 * 256] = (bf16_t)w0; vt[1 * 256] = (bf16_t)(w0 >> 16); vt[2 * 256] = (bf16_t)w1; vt[3 * 256] = (bf16_t)(w1 >> 16);
                            vt[4 * 256] = (bf16_t)w2; vt[5 * 256] = (bf16_t)(w2 >> 16); vt[6 * 256] = (bf16_t)w3; vt[7 * 256] = (bf16_t)(w3 >> 16);
                        }
                    }
                }
            }
    }
};
struct BranchOrder {
    int G, c;
    __device__ bool next(int i, Unit& u) const { const int b = i % 3, t = (i / 3) * G + c; if (t >= 256) return false; u.pm = b * 64 + (t >> 2); u.pn = b * 4 + (t & 3); return true; }
    __device__ __forceinline__ void a_ready(const Unit&) const {}
    __device__ __forceinline__ void done(const Unit&) const {}
};
struct CkvOrder {
    int G, c;
    __device__ bool next(int i, Unit& u) const { const int t = i * G + c; if (t >= 256) return false; const int l = t >> 6; u.pm = l * 8 + ((t >> 3) & 7); u.pn = l * 8 + (t & 7); return true; }
    __device__ __forceinline__ void a_ready(const Unit&) const {}
    __device__ __forceinline__ void done(const Unit&) const {}
};
template <class Epi, class Sched, bool ALIGN_EPI = false, bool SP2 = false>
__device__ __forceinline__ void gemm_phase(PG8_LAS unsigned char* lds, const Gemm g, const Sched& S, const Epi& E, int wave_id) {
    int tid_ = wave_id * 64 + (int)__builtin_amdgcn_mbcnt_hi(~0u, __builtin_amdgcn_mbcnt_lo(~0u, 0u)); asm volatile("" : "+v"(tid_));
    const int tid = tid_, wid = __builtin_amdgcn_readfirstlane(tid >> 6), lane = tid & 63, wr = wid >> 2, wc = wid & 3, fr = lane & 15, fq = lane >> 4;
    const int K = g.K, nt = K / BK;
    unsigned voffA[2], voffB[2];
#pragma unroll
    for (int i = 0; i < 2; ++i) { int R, C; stage_rc(tid * 16 + i * 8192, R, C); const int Rb = Epi::PERM ? ((R & ~31) + perm32(R & 31)) : R;
        voffA[i] = (unsigned)(R * K + C) * 2u; voffB[i] = (unsigned)(Rb * K + C) * 2u; }
    const size_t kstep = (size_t)(BK * 2);
    const size_t hstep = (size_t)HALF * K * 2;
    const size_t tstep = 2 * hstep;
    const unsigned ldsw = (unsigned)wid * 1024u;
    const int aoff = lds_byte(wr * 64 + fr, fq * 8), boff = lds_byte(wc * 32 + fr, fq * 8);
#define PG8_SA(b, h) (((b) * 2 + (h)) * HTB)
#define PG8_SB(b, h) ((4 + (b) * 2 + (h)) * HTB)
#define PG8_STAGE(bufoff, gbase, voff) do { _Pragma("unroll") for (int _i = 0; _i < 2; ++_i) \
        __builtin_amdgcn_global_load_lds((const unsigned*)((const char*)(gbase) + (voff)[_i]), (PG8_LAS unsigned*)(lds + (bufoff) + ldsw + _i * 8192), 16, 0, 0); } while (0)
#define PG8_LDA(dst, b, h) do { _Pragma("unroll") for (int m = 0; m < 4; ++m) _Pragma("unroll") for (int k = 0; k < 2; ++k) dst[m][k] = *(const PG8_LAS bf16x8*)(lds + PG8_SA(b, h) + aoff + m * 2048 + k * 1024); } while (0)
#define PG8_LDB(dst, b, h) do { _Pragma("unroll") for (int n = 0; n < 2; ++n) _Pragma("unroll") for (int k = 0; k < 2; ++k) dst[n][k] = *(const PG8_LAS bf16x8*)(lds + PG8_SB(b, h) + boff + n * 2048 + k * 1024); } while (0)
#define PG8_MMA(ai, bj, At, Bt) do { __builtin_amdgcn_s_setprio(1); _Pragma("unroll") for (int m = 0; m < 4; ++m) _Pragma("unroll") for (int n = 0; n < 2; ++n) _Pragma("unroll") for (int k = 0; k < 2; ++k) \
        acc[ai][bj][m][n] = __builtin_amdgcn_mfma_f32_16x16x32_bf16(Bt[n][k], At[m][k], acc[ai][bj][m][n], 0, 0, 0); __builtin_amdgcn_s_setprio(0); } while (0)
#define PG8_WAIT_V(n) asm volatile("s_waitcnt vmcnt(" #n ")" ::: "memory")
#define PG8_WAIT_L(n) asm volatile("s_waitcnt lgkmcnt(" #n ")" ::: "memory")
#define PG8_BAR __builtin_amdgcn_s_barrier()
#define PG8_SCHED __builtin_amdgcn_sched_barrier(0)
    Unit cur, nxt; int ui = 0;
    if (!S.next(0, cur)) return;
    f32x4 acc[2][2][4][2];
#pragma unroll
    for (int a = 0; a < 2; ++a)
#pragma unroll
        for (int b = 0; b < 2; ++b)
#pragma unroll
            for (int m = 0; m < 4; ++m)
#pragma unroll
                for (int n = 0; n < 2; ++n) acc[a][b][m][n] = (f32x4){0.f, 0.f, 0.f, 0.f};
    bf16x8 At[4][2], B0[2][2], B1[2][2];
    const char* cA = (const char*)g.A + (size_t)cur.pm * tstep; const char* cB = (const char*)g.Bt + (size_t)cur.pn * tstep;
    S.a_ready(cur);
    if constexpr (SP2) {
        PG8_STAGE(PG8_SB(0, 0), cB, voffB); PG8_STAGE(PG8_SB(0, 1), cB + hstep, voffB); PG8_STAGE(PG8_SA(0, 0), cA, voffA); PG8_STAGE(PG8_SA(0, 1), cA + hstep, voffA);
        if (wr == 1) PG8_BAR;
        PG8_WAIT_V(2); PG8_BAR;
        PG8_STAGE(PG8_SB(1, 0), cB + kstep, voffB); PG8_STAGE(PG8_SA(1, 0), cA + kstep, voffA); PG8_STAGE(PG8_SB(1, 1), cB + hstep + kstep, voffB);
        PG8_WAIT_V(6); PG8_BAR;
    } else {
        PG8_STAGE(PG8_SB(0, 0), cB, voffB); PG8_STAGE(PG8_SA(0, 0), cA, voffA); PG8_STAGE(PG8_SB(0, 1), cB + hstep, voffB); PG8_STAGE(PG8_SA(0, 1), cA + hstep, voffA);
        if (wr == 1) PG8_BAR;
        PG8_WAIT_V(4); PG8_BAR;
        PG8_STAGE(PG8_SB(1, 0), cB + kstep, voffB); PG8_STAGE(PG8_SA(1, 0), cA + kstep, voffA); PG8_STAGE(PG8_SB(1, 1), cB + hstep + kstep, voffB);
        PG8_WAIT_V(6); PG8_BAR;
    }
    for (;;) {
        const bool has_next = S.next(ui + 1, nxt);
        const char* nA = has_next ? (const char*)g.A + (size_t)nxt.pm * tstep : cA; const char* nB = has_next ? (const char*)g.Bt + (size_t)nxt.pn * tstep : cB;
        for (int t = 0; t < nt; t += 2) {
            const bool last = (t == nt - 2);
            const char* a1 = cA + (size_t)(t + 1) * kstep;
            const char* a2 = last ? nA : cA + (size_t)(t + 2) * kstep; const char* b2 = last ? nB : cB + (size_t)(t + 2) * kstep;
            const char* a3 = a2 + kstep; const char* b3 = b2 + kstep;
            if (last && has_next) S.a_ready(nxt);
            if constexpr (SP2) {
            PG8_LDB(B0, 0, 0); PG8_LDB(B1, 0, 1); PG8_SCHED; PG8_LDA(At, 0, 0); PG8_STAGE(PG8_SA(1, 1), a1 + hstep, voffA);
            PG8_WAIT_V(8); PG8_WAIT_L(0); PG8_BAR; PG8_MMA(0, 0, At, B0); PG8_MMA(0, 1, At, B1); PG8_BAR; PG8_SCHED;
            PG8_LDA(At, 0, 1); PG8_STAGE(PG8_SB(0, 0), b2, voffB); PG8_STAGE(PG8_SB(0, 1), b2 + hstep, voffB); PG8_STAGE(PG8_SA(0, 0), a2, voffA);
            PG8_WAIT_V(8); PG8_WAIT_L(0); PG8_BAR; PG8_MMA(1, 0, At, B0); PG8_MMA(1, 1, At, B1); PG8_BAR; PG8_SCHED;
            PG8_LDB(B0, 1, 0); PG8_LDB(B1, 1, 1); PG8_SCHED; PG8_LDA(At, 1, 0); PG8_STAGE(PG8_SA(0, 1), a2 + hstep, voffA);
            PG8_WAIT_V(8); PG8_WAIT_L(0); PG8_BAR; PG8_MMA(0, 0, At, B0); PG8_MMA(0, 1, At, B1); PG8_BAR; PG8_SCHED;
            PG8_LDA(At, 1, 1); PG8_STAGE(PG8_SB(1, 0), b3, voffB); PG8_STAGE(PG8_SB(1, 1), b3 + hstep, voffB); PG8_STAGE(PG8_SA(1, 0), a3, voffA);
            PG8_WAIT_V(8); PG8_WAIT_L(0); PG8_BAR; PG8_MMA(1, 0, At, B0); PG8_MMA(1, 1, At, B1); PG8_BAR; PG8_SCHED;
            } else {
            PG8_LDB(B0, 0, 0); PG8_SCHED; PG8_LDA(At, 0, 0); PG8_STAGE(PG8_SA(1, 1), a1 + hstep, voffA);
            PG8_WAIT_L(8); PG8_BAR; PG8_WAIT_L(0); PG8_MMA(0, 0, At, B0); PG8_BAR; PG8_SCHED;
            PG8_LDB(B1, 0, 1); PG8_STAGE(PG8_SB(0, 0), b2, voffB);
            PG8_BAR; PG8_WAIT_L(0); PG8_MMA(0, 1, At, B1); PG8_BAR;
            PG8_LDA(At, 0, 1); PG8_STAGE(PG8_SA(0, 0), a2, voffA);
            PG8_BAR; PG8_WAIT_L(0); PG8_MMA(1, 0, At, B0); PG8_BAR; PG8_SCHED;
            PG8_STAGE(PG8_SB(0, 1), b2 + hstep, voffB);
            PG8_WAIT_V(6); PG8_BAR; PG8_MMA(1, 1, At, B1); PG8_BAR;
            PG8_LDB(B0, 1, 0); PG8_SCHED; PG8_LDA(At, 1, 0); PG8_STAGE(PG8_SA(0, 1), a2 + hstep, voffA);
            PG8_WAIT_L(8); PG8_BAR; PG8_WAIT_L(0); PG8_MMA(0, 0, At, B0); PG8_BAR; PG8_SCHED;
            PG8_LDB(B1, 1, 1); PG8_STAGE(PG8_SB(1, 0), b3, voffB);
            PG8_BAR; PG8_WAIT_L(0); PG8_MMA(0, 1, At, B1); PG8_BAR;
            PG8_LDA(At, 1, 1); PG8_STAGE(PG8_SA(1, 0), a3, voffA);
            PG8_BAR; PG8_WAIT_L(0); PG8_MMA(1, 0, At, B0); PG8_BAR; PG8_SCHED;
            PG8_STAGE(PG8_SB(1, 1), b3 + hstep, voffB);
            PG8_WAIT_V(6); PG8_BAR; PG8_MMA(1, 1, At, B1); PG8_BAR;
            }
        }
        if constexpr (ALIGN_EPI) { if (wr == 0) PG8_BAR; }
        if constexpr (!Epi::AFTER_DRAIN) { E(acc, cur, wr, wc, fr, fq); S.done(cur); }
        if (!has_next) break;
#pragma unroll
        for (int a = 0; a < 2; ++a)
#pragma unroll
            for (int b = 0; b < 2; ++b)
#pragma unroll
                for (int m = 0; m < 4; ++m)
#pragma unroll
                    for (int n = 0; n < 2; ++n) acc[a][b][m][n] = (f32x4){0.f, 0.f, 0.f, 0.f};
        cur = nxt; cA = nA; cB = nB; ++ui;
        if constexpr (ALIGN_EPI) { if (wr == 1) PG8_BAR; }
    }
    PG8_WAIT_V(0);
    if constexpr (!ALIGN_EPI) { if (wr == 0) PG8_BAR; }
    PG8_BAR;
    if constexpr (Epi::AFTER_DRAIN) { E.fused(acc, cur, wr, wc, fr, fq, lds, wid, lane); S.done(cur); }
#undef PG8_SA
#undef PG8_SB
#undef PG8_STAGE
#undef PG8_LDA
#undef PG8_LDB
#undef PG8_MMA
#undef PG8_WAIT_V
#undef PG8_WAIT_L
#undef PG8_BAR
#undef PG8_SCHED
}
}
#define GAS __attribute__((address_space(1)))
#define LAS __attribute__((address_space(3)))
typedef unsigned short bf16;
typedef unsigned v4u __attribute__((ext_vector_type(4)));
typedef float f32x4 __attribute__((ext_vector_type(4)));
typedef short bf16x8 __attribute__((ext_vector_type(8)));
typedef GAS unsigned gu32;
typedef GAS unsigned long long gu64;
#define RLX_AGENT __ATOMIC_RELAXED, __HIP_MEMORY_SCOPE_AGENT
#define LDS_WAIT() asm volatile("s_waitcnt lgkmcnt(0)" ::: "memory")
#define VM_WAIT() asm volatile("s_waitcnt vmcnt(0)" ::: "memory")
__device__ __forceinline__ unsigned long long rt() { return __builtin_amdgcn_s_memrealtime(); }
__device__ __forceinline__ unsigned f2bf(float f) { unsigned u = __builtin_bit_cast(unsigned, f); return (u + 0x7fffu + ((u >> 16) & 1u)) >> 16; }
__device__ __forceinline__ unsigned pk2(float lo, float hi) { return f2bf(lo) | (f2bf(hi) << 16); }

#define XB_TMO      128
#define XB_XCNT(j)  (256  + 64 * (j))
#define XB_XSUB(j)  (1280 + 64 * (j))
#define XB_XGEN(j)  (2304 + 64 * (j))
#define XB_TOP      3328
#define XB_TOPGEN   3392
#define XCD_BAR_WORDS 3456
#define XB_SPIN_CAP (1u << 18)

__device__ __forceinline__ unsigned xb_ld(unsigned* p)              { return __hip_atomic_load(p, __ATOMIC_RELAXED, __HIP_MEMORY_SCOPE_AGENT); }
__device__ __forceinline__ unsigned xb_add(unsigned* p, unsigned v) { return __hip_atomic_fetch_add(p, v, __ATOMIC_RELAXED, __HIP_MEMORY_SCOPE_AGENT); }
__device__ __forceinline__ unsigned xb_xcc_id() { return (unsigned)__builtin_amdgcn_s_getreg((3 << 11) | 20) & 0xFu; }
#define XB_SPIN(cond, bar) do { unsigned _sp = 0; while (cond) { __builtin_amdgcn_s_sleep(1); \
    if ((++_sp & 255u) == 0u) { if (xb_ld(&(bar)[XB_TMO])) break; if (_sp > XB_SPIN_CAP) { atomicAdd(&(bar)[XB_TMO], 1u); break; } } } } while (0)

struct XcdBarrier {
    unsigned* bar; unsigned x;
    volatile LAS unsigned* st;
};

__device__ __forceinline__ XcdBarrier xcd_barrier_post(unsigned* bar, volatile LAS unsigned* st) {
    XcdBarrier b; b.bar = bar; b.x = xb_xcc_id(); b.st = st;
    if (threadIdx.x == 0) (void)xb_add(&bar[XB_XCNT(b.x)], 1u);
    return b;
}
__device__ __forceinline__ void xcd_barrier_complete(unsigned* bar, unsigned x, unsigned& nloc, unsigned& nx) {
    const unsigned G = gridDim.x * gridDim.y * gridDim.z;
    unsigned sum, cnt, mine, sp = 0u;
    for (;;) {
        sum = 0u; cnt = 0u; mine = 0u;
#pragma unroll
        for (unsigned j = 0; j < 16; ++j) { const unsigned c = xb_ld(&bar[XB_XCNT(j)]); sum += c; cnt += (c > 0u) ? 1u : 0u; mine = (j == x) ? c : mine; }
        if (sum == G) break;
        __builtin_amdgcn_s_sleep(1);
        if ((++sp & 255u) == 0u) { if (xb_ld(&bar[XB_TMO])) break; if (sp > XB_SPIN_CAP) { atomicAdd(&bar[XB_TMO], 1u); break; } }
    }
    nloc = mine > 0u ? mine : 1u; nx = cnt > 0u ? cnt : 1u;
}

__device__ __forceinline__ void xcd_barrier(const XcdBarrier& b) {
    asm volatile("s_waitcnt vmcnt(0)" ::: "memory");
    __syncthreads();
    if (threadIdx.x == 0) {
        unsigned* bar = b.bar;
        __builtin_amdgcn_s_waitcnt(0);
        unsigned nloc = b.st[0], nx = b.st[1];
        if (nloc == 0u) { xcd_barrier_complete(bar, b.x, nloc, nx); b.st[0] = nloc; b.st[1] = nx; }
        const unsigned old = xb_add(&bar[XB_XSUB(b.x)], 1u);
        const unsigned gen = old / nloc;
        if (old + 1u == (gen + 1u) * nloc) {
            __builtin_amdgcn_fence(__ATOMIC_RELEASE, "agent");
            asm volatile("s_waitcnt vmcnt(0)" ::: "memory");
            const unsigned og = xb_add(&bar[XB_TOP], 1u);
            const unsigned tg = og / nx;
            if (og + 1u == (tg + 1u) * nx) xb_add(&bar[XB_TOPGEN], 1u);
            else XB_SPIN(xb_ld(&bar[XB_TOPGEN]) == tg, bar);
            __builtin_amdgcn_fence(__ATOMIC_ACQUIRE, "agent");
            xb_add(&bar[XB_XGEN(b.x)], 1u);
            asm volatile("s_waitcnt vmcnt(0)" ::: "memory");
        } else {
            XB_SPIN(xb_ld(&bar[XB_XGEN(b.x)]) == gen, bar);
            __builtin_amdgcn_fence(__ATOMIC_ACQUIRE, "agent");
            asm volatile("s_waitcnt vmcnt(0)" ::: "memory");
        }
    }
    __syncthreads();
}

#ifndef MK_PER_PHASE
#define MK_PER_PHASE 0
#endif
constexpr int NWAVES = 8;
constexpr int DM = 1024, NB = 8, SEQ = 2048, M = NB * SEQ, DEPTH = 4, DFF = 2816, NMEM = 256;
constexpr int INW = 6560;
constexpr int NRA = 5376;
constexpr int NWIN = 8448;
constexpr float EPS = 1e-6f;
constexpr float LOG2E = 1.4426950408889634f;
constexpr size_t MiB = 1u << 20;
constexpr size_t WS_CTL = 0, CTL_BYTES = 1 * MiB;
constexpr size_t WS_TAB = 1 * MiB;
constexpr size_t WS_W = 9 * MiB;
constexpr size_t W_13A = 0, W_2A = 11 * MiB, W_IN = 16 * MiB + 512 * 1024, W_BR = 33 * MiB, W_OUT = 36 * MiB, W_CQ = 38 * MiB, W_CO = 40 * MiB, W_13B = 42 * MiB, W_2B = 53 * MiB;
constexpr size_t WS_XB = 73 * MiB;
constexpr size_t WS_CK = 105 * MiB, WS_CVT = 121 * MiB;
constexpr size_t WS_KVC = 137 * MiB;
constexpr size_t WS_YBR = 171 * MiB;
constexpr size_t WS_RA = 219 * MiB;
constexpr size_t WS_ACT = WS_RA, WS_Z = WS_RA, WS_CQ = WS_RA, WS_CO = WS_RA + 32 * MiB, WS_Y = WS_RA + 96 * MiB;
constexpr size_t WS_PREP = 387 * MiB;
constexpr size_t P_RQ = 0, P_RK = 8 * MiB, P_RKDT = 16 * MiB, P_RVT = 24 * MiB, P_MQ = 40 * MiB, P_MK = 64 * MiB, P_MVT = 88 * MiB, P_DQ = 104 * MiB, P_DK = 120 * MiB, P_DVT = 136 * MiB;
constexpr size_t WS_G = WS_PREP + 40 * MiB;
constexpr size_t WS_T_WKV = WS_PREP, WS_T_MEMN = WS_PREP + 16 * MiB;
constexpr size_t WS_END = 539 * MiB;
constexpr int CW_BAR = 4096, CW_WQ = 16384, CW_LAM = 36000;

constexpr int RING_BYTES = 131072, LDSCTL_OFF = RING_BYTES, MISC_OFF = LDSCTL_OFF + 320, LDS_BYTES = 147456;

typedef short s16x4 __attribute__((ext_vector_type(4)));
typedef unsigned u32x2 __attribute__((ext_vector_type(2)));

struct Args {
    const float* in[22]; float* out; unsigned char* ws;
    float inv_freq[56]; float lam_init[4]; float log2g[4];
    int ph_lo, ph_hi;
};

struct Frame {
    LAS unsigned char* lds; volatile LAS unsigned* MISC; unsigned* ctl;
    int tid, lane, wave, G, gw, NGW;
    unsigned char* ws;
};

__device__ __forceinline__ float wave_sum(float v) {
#pragma unroll
    for (int o = 1; o < 64; o <<= 1) v += __shfl_xor(v, o);
    return v;
}
__device__ __forceinline__ float bflo(unsigned w) { return __uint_as_float(w << 16); }
__device__ __forceinline__ float bfhi(unsigned w) { return __uint_as_float(w & 0xffff0000u); }
__device__ __forceinline__ float bf1(bf16 h) { return __uint_as_float((unsigned)h << 16); }
__device__ __forceinline__ unsigned cvtpk(float lo, float hi) { return pg8::cvt_pk_bf16(lo, hi); }
__device__ __forceinline__ unsigned wq_next(unsigned* ctr, int lane) { unsigned v = 0; if (lane == 0) v = atomicAdd(ctr, 1u); return (unsigned)__builtin_amdgcn_readfirstlane((int)v); }

template <class CMap>
__device__ __forceinline__ void conv_item(const float* W, int ldw, int K, bf16* Bt, int k0, int n0, float scale, const CMap& cmap, LAS float* scr, int lane) {
    const int src = cmap(n0 + (lane & 31));
#pragma unroll 8
    for (int i = 0; i < 32; ++i) { const int kk = 2 * i + (lane >> 5); scr[kk * 33 + (lane & 31)] = src >= 0 ? W[(size_t)(k0 + kk) * ldw + src] * scale : 0.f; }
    LDS_WAIT(); asm volatile("" ::: "memory");
    const int c = lane & 7;
#pragma unroll
    for (int j = 0; j < 4; ++j) { const int n = (lane >> 3) + 8 * j; const LAS float* s = scr + (8 * c) * 33 + n;
        v4u o; o.x = cvtpk(s[0 * 33], s[1 * 33]); o.y = cvtpk(s[2 * 33], s[3 * 33]); o.z = cvtpk(s[4 * 33], s[5 * 33]); o.w = cvtpk(s[6 * 33], s[7 * 33]);
        *(v4u*)(Bt + (size_t)(n0 + n) * K + k0 + 8 * c) = o; }
    LDS_WAIT(); asm volatile("" ::: "memory");
}
struct MapId { __device__ int operator()(int n) const { return n; } };
struct MapSwiglu { __device__ int operator()(int n) const { const int j = n & 7, g = n >> 3; return j < 4 ? 4 * g + j : DFF + 4 * g + (j - 4); } };
struct MapWin {
    __device__ int operator()(int n) const {
        if (n < 1792) return n;
        if (n < 2048) { const int o = n - 1792; return o < 160 ? 1792 + o : -1; }
        if (n < 3584) return 1952 + (n - 2048);
        if (n < NRA) return -2;
        return 3488 + (n - NRA);
    }
};
__device__ __forceinline__ void fold_item(const float* win, int c0, int R, const float* g, const float* wb, int ldb, bf16* Bt  , int n0, int k0, int lane) {
    float acc[16];
#pragma unroll
    for (int i = 0; i < 16; ++i) acc[i] = 0.f;
    for (int r = 0; r < R; ++r) {
        const float a = g[r] * wb[(size_t)r * ldb + n0 + lane];
#pragma unroll
        for (int i = 0; i < 16; ++i) acc[i] += win[(size_t)(k0 + i) * INW + c0 + r] * a;
    }
    v4u o0, o1;
    o0.x = cvtpk(acc[0], acc[1]); o0.y = cvtpk(acc[2], acc[3]); o0.z = cvtpk(acc[4], acc[5]); o0.w = cvtpk(acc[6], acc[7]);
    o1.x = cvtpk(acc[8], acc[9]); o1.y = cvtpk(acc[10], acc[11]); o1.z = cvtpk(acc[12], acc[13]); o1.w = cvtpk(acc[14], acc[15]);
    bf16* p = Bt + (size_t)(n0 + lane) * DM + k0; *(v4u*)p = o0; *(v4u*)(p + 8) = o1;
}
__device__ __forceinline__ void wconv_layer(Frame& F, const Args& a, int l) {
    LAS float* scr = (LAS float*)(F.lds + F.wave * 16384);
    unsigned char* wb = F.ws + WS_W;
    const float* w13a = a.in[4] + (size_t)l * DM * 2 * DFF; const float* w2a = a.in[5] + (size_t)l * DFF * DM;
    const float* win = a.in[7] + (size_t)l * DM * INW;
    const float* wbr = a.in[13] + (size_t)l * 3 * 512 * DM; const float* wout = a.in[14] + (size_t)l * DM * DM;
    const float* cwq = a.in[16] + (size_t)l * DM * DM; const float* cwo = a.in[18] + (size_t)l * DM * DM;
    const float* w13b = a.in[20] + (size_t)l * DM * 2 * DFF; const float* w2b = a.in[21] + (size_t)l * DFF * DM;
    constexpr int I_13 = 16 * 176, I_2 = 44 * 32, I_IN = 16 * 264, I_BR = 8 * 32, I_SQ = 16 * 32;
    constexpr int I_FQ = 12 * 64, I_FKV = 16 * 64;
    constexpr int NIT = 2 * I_13 + 2 * I_2 + I_IN + 3 * I_BR + 3 * I_SQ + I_FQ + I_FKV;
    for (int it = F.gw; it < NIT; it += F.NGW) {
        int r = it;
        if (r < I_FQ) { fold_item(win, 1536, 256, a.in[8] + l * 256, a.in[10] + (size_t)l * 256 * 768, 768, (bf16*)(wb + W_IN) + (size_t)3584 * DM, (r % 12) * 64, (r / 12) * 16, F.lane); continue; } r -= I_FQ;
        if (r < I_FKV) { fold_item(win, 1792, 128, a.in[9] + l * 128, a.in[11] + (size_t)l * 128 * 1024, 1024, (bf16*)(wb + W_IN) + (size_t)4352 * DM, (r % 16) * 64, (r / 16) * 16, F.lane); continue; } r -= I_FKV;
        if (r < I_13) { conv_item(w13a, 2 * DFF, DM, (bf16*)(wb + W_13A), (r / 176) * 64, (r % 176) * 32, 1.f, MapSwiglu(), scr, F.lane); continue; } r -= I_13;
        if (r < I_13) { conv_item(w13b, 2 * DFF, DM, (bf16*)(wb + W_13B), (r / 176) * 64, (r % 176) * 32, 1.f, MapSwiglu(), scr, F.lane); continue; } r -= I_13;
        if (r < I_2) { conv_item(w2a, DM, DFF, (bf16*)(wb + W_2A), (r / 32) * 64, (r % 32) * 32, 1.f, MapId(), scr, F.lane); continue; } r -= I_2;
        if (r < I_2) { conv_item(w2b, DM, DFF, (bf16*)(wb + W_2B), (r / 32) * 64, (r % 32) * 32, 1.f, MapId(), scr, F.lane); continue; } r -= I_2;
        if (r < I_IN) { const int nb = r % 264, n0 = nb * 32; if (n0 >= 3584 && n0 < NRA) continue; conv_item(win, INW, DM, (bf16*)(wb + W_IN), (r / 264) * 64, n0, 1.f, MapWin(), scr, F.lane); continue; } r -= I_IN;
        if (r < 3 * I_BR) { const int b = r / I_BR, q = r % I_BR; conv_item(wbr + (size_t)b * 512 * DM, DM, 512, (bf16*)(wb + W_BR) + (size_t)b * DM * 512, (q / 32) * 64, (q % 32) * 32, 1.f, MapId(), scr, F.lane); continue; } r -= 3 * I_BR;
        if (r < I_SQ) { conv_item(wout, DM, DM, (bf16*)(wb + W_OUT), (r / 32) * 64, (r % 32) * 32, 1.f, MapId(), scr, F.lane); continue; } r -= I_SQ;
        if (r < I_SQ) { conv_item(cwq, DM, DM, (bf16*)(wb + W_CQ), (r / 32) * 64, (r % 32) * 32, 0.0625f * LOG2E, MapId(), scr, F.lane); continue; } r -= I_SQ;
        conv_item(cwo, DM, DM, (bf16*)(wb + W_CO), (r / 32) * 64, (r % 32) * 32, 1.f, MapId(), scr, F.lane);
    }
}

__device__ __forceinline__ void ew_phase(Frame& F, const float* xin, const float* y, const float* gpost, float scale, const float* gpre, float* xout, bf16* xb) {
    for (int row = F.gw; row < M; row += F.NGW) {
        const f32x4* xr = (const f32x4*)(xin + (size_t)row * DM) + F.lane;
        f32x4 xv[4];
#pragma unroll
        for (int j = 0; j < 4; ++j) xv[j] = xr[64 * j];
        if (y) {
            const f32x4* yr = (const f32x4*)(y + (size_t)row * DM) + F.lane; f32x4 yv[4]; float s = 0.f;
#pragma unroll
            for (int j = 0; j < 4; ++j) { yv[j] = yr[64 * j]; s += (yv[j].x * yv[j].x + yv[j].y * yv[j].y) + (yv[j].z * yv[j].z + yv[j].w * yv[j].w); }
            const float rs = scale * rsqrtf(wave_sum(s) * (1.f / DM) + EPS);
#pragma unroll
            for (int j = 0; j < 4; ++j) { const f32x4 g = ((const f32x4*)gpost)[F.lane + 64 * j]; xv[j] = xv[j] + yv[j] * g * rs; }
        }
        f32x4* xo = (f32x4*)(xout + (size_t)row * DM) + F.lane;
#pragma unroll
        for (int j = 0; j < 4; ++j) xo[64 * j] = xv[j];
        if (gpre) {
            float s = 0.f;
#pragma unroll
            for (int j = 0; j < 4; ++j) s += (xv[j].x * xv[j].x + xv[j].y * xv[j].y) + (xv[j].z * xv[j].z + xv[j].w * xv[j].w);
            const float rs = rsqrtf(wave_sum(s) * (1.f / DM) + EPS);
            u32x2* o8 = (u32x2*)(xb + (size_t)row * DM) + F.lane;
#pragma unroll
            for (int j = 0; j < 4; ++j) { const f32x4 g = ((const f32x4*)gpre)[F.lane + 64 * j]; const f32x4 v = xv[j] * g * rs; u32x2 w; w.x = cvtpk(v.x, v.y); w.y = cvtpk(v.z, v.w); o8[64 * j] = w; }
        }
    }
}

__device__ __forceinline__ void init_phase(Frame& F, const Args& a) {
    if (F.gw < DEPTH) { const int l = F.gw; const float* lp = a.in[12] + (size_t)l * 256;
        const float s01 = wave_sum(lp[F.lane] * lp[64 + F.lane]), s23 = wave_sum(lp[128 + F.lane] * lp[192 + F.lane]);
        if (F.lane == 0) ((float*)(F.ctl + CW_LAM))[l] = __expf(s01) - __expf(s23) + a.lam_init[l]; }
    float* tab = (float*)(F.ws + WS_TAB); const int* pos = (const int*)a.in[2];
    for (int e = blockIdx.x * 512 + F.tid; e < M * 56; e += F.G * 512) {
        const int t = e / 56, i = e % 56; const double ang = (double)pos[t] * (double)a.inv_freq[i];
        const double rev = ang * 0.15915494309189535; const float fr = (float)(rev - __builtin_rint(rev));
        tab[2 * e] = __builtin_amdgcn_cosf(fr); tab[2 * e + 1] = __builtin_amdgcn_sinf(fr);
    }
    const float* mem = a.in[1]; bf16* memn = (bf16*)(F.ws + WS_T_MEMN);
    for (int row = F.gw; row < NB * NMEM; row += F.NGW) {
        const f32x4* xr = (const f32x4*)(mem + (size_t)row * DM) + F.lane; f32x4 xv[4]; float s = 0.f;
#pragma unroll
        for (int j = 0; j < 4; ++j) { xv[j] = xr[64 * j]; s += (xv[j].x * xv[j].x + xv[j].y * xv[j].y) + (xv[j].z * xv[j].z + xv[j].w * xv[j].w); }
        const float rs = rsqrtf(wave_sum(s) * (1.f / DM) + EPS);
        for (int l = 0; l < DEPTH; ++l) { const float* g2 = a.in[15] + (size_t)(l * 3 + 2) * DM; u32x2* o8 = (u32x2*)(memn + ((size_t)l * 2048 + row) * DM) + F.lane;
#pragma unroll
            for (int j = 0; j < 4; ++j) { const f32x4 g = ((const f32x4*)g2)[F.lane + 64 * j]; const f32x4 v = xv[j] * g * rs; u32x2 w; w.x = cvtpk(v.x, v.y); w.y = cvtpk(v.z, v.w); o8[64 * j] = w; } }
    }
    LAS float* scr = (LAS float*)(F.lds + F.wave * 16384);
    for (int it = F.gw; it < DEPTH * 16 * 64; it += F.NGW) { const int l = it / 1024, r = it % 1024;
        conv_item(a.in[17] + (size_t)l * DM * 2048, 2048, DM, (bf16*)(F.ws + WS_T_WKV) + (size_t)l * 2048 * DM, (r / 64) * 64, (r % 64) * 32, 1.f, MapId(), scr, F.lane); }
}

__device__ __forceinline__ void ld8(const bf16* p, float (&v)[8]) {
    const v4u w = *(const v4u*)p; v[0] = bflo(w.x); v[1] = bfhi(w.x); v[2] = bflo(w.y); v[3] = bfhi(w.y); v[4] = bflo(w.z); v[5] = bfhi(w.z); v[6] = bflo(w.w); v[7] = bfhi(w.w);
}
__device__ __forceinline__ void st8(bf16* p, const float (&v)[8]) { v4u w; w.x = cvtpk(v[0], v[1]); w.y = cvtpk(v[2], v[3]); w.z = cvtpk(v[4], v[5]); w.w = cvtpk(v[6], v[7]); *(v4u*)p = w; }
__device__ __forceinline__ void rope8(const bf16* vec, int H, int p0, const float* tab, float scale, float (&out)[8]) {
    const int i0 = p0 < H ? p0 : p0 - H; float x1[8], x2[8]; ld8(vec + i0, x1); ld8(vec + H + i0, x2);
    const f32x4* tp = (const f32x4*)(tab + 2 * i0); const f32x4 t0 = tp[0], t1 = tp[1], t2 = tp[2], t3 = tp[3];
    const float c[8] = {t0.x, t0.z, t1.x, t1.z, t2.x, t2.z, t3.x, t3.z}, s[8] = {t0.y, t0.w, t1.y, t1.w, t2.y, t2.w, t3.y, t3.w};
    if (p0 < H) {
#pragma unroll
        for (int i = 0; i < 8; ++i) out[i] = (x1[i] * c[i] - x2[i] * s[i]) * scale;
    } else {
#pragma unroll
        for (int i = 0; i < 8; ++i) out[i] = (x2[i] * c[i] + x1[i] * s[i]) * scale;
    }
}
__device__ __forceinline__ void prep_phase(Frame& F, const Args& a) {
    const bf16* R = (const bf16*)(F.ws + WS_RA); const float* tab = (const float*)(F.ws + WS_TAB); unsigned char* P = F.ws + WS_PREP;
    LAS float* rq = (LAS float*)F.lds; LAS float* rkv = rq + 64;
    for (int ch = blockIdx.x; ch < M / 64; ch += F.G) {
        const int tok0 = ch * 64, b = tok0 / SEQ, s0 = tok0 % SEQ;
        for (int i = 0; i < 8; ++i) { const int tl = F.wave * 8 + i; const bf16* r = R + (size_t)(tok0 + tl) * NRA;
            const u32x2 w = *(const u32x2*)(r + 1536 + F.lane * 4); float s = bflo(w.x) * bflo(w.x) + bfhi(w.x) * bfhi(w.x) + bflo(w.y) * bflo(w.y) + bfhi(w.y) * bfhi(w.y);
            s = wave_sum(s); const unsigned w2 = *(const unsigned*)(r + 1792 + F.lane * 2); float s2 = bflo(w2) * bflo(w2) + bfhi(w2) * bfhi(w2); s2 = wave_sum(s2);
            if (F.lane == 0) { rq[tl] = rsqrtf(s * (1.f / 256.f) + EPS); rkv[tl] = rsqrtf(s2 * (1.f / 128.f) + EPS); } }
        __syncthreads();
        for (int i = F.tid; i < 64 * 32; i += 512) { const int tl = i >> 5, g = i & 31, tok = tok0 + tl, h = g >> 3, p0 = (g & 7) * 8; const bf16* r = R + (size_t)tok * NRA; float o[8];
            rope8(r + h * 64, 32, p0, tab + (size_t)tok * 112, 0.125f, o); st8((bf16*)(P + P_RQ) + (size_t)tok * 256 + g * 8, o);
            rope8(r + 256 + h * 64, 32, p0, tab + (size_t)tok * 112, 1.f, o); st8((bf16*)(P + P_RK) + (size_t)tok * 256 + g * 8, o); }
        for (int i = F.tid; i < 64 * 96; i += 512) { const int tl = i / 96, g = i % 96, tok = tok0 + tl, h = g / 12, j0 = (g % 12) * 8; const bf16* r = R + (size_t)tok * NRA; float o[8];
            const float sq = rq[tl] * (0.10206207261596577f * LOG2E), skv = rkv[tl];
            if (j0 < 64) { ld8(r + 3584 + h * 96 + j0, o);
#pragma unroll
                for (int e = 0; e < 8; ++e) o[e] *= sq; }
            else rope8(r + 3584 + h * 96 + 64, 16, j0 - 64, tab + (size_t)tok * 112 + 64, sq, o);
            st8((bf16*)(P + P_MQ) + (size_t)tok * 768 + g * 8, o);
            if (j0 < 64) { ld8(r + 4352 + h * 128 + j0, o);
#pragma unroll
                for (int e = 0; e < 8; ++e) o[e] *= skv; }
            else rope8(r + 1792 + 128, 16, j0 - 64, tab + (size_t)tok * 112 + 64, 1.f, o);
            st8((bf16*)(P + P_MK) + (size_t)tok * 768 + g * 8, o); }
        for (int i = F.tid; i < 64 * 64; i += 512) { const int tl = i >> 6, g = i & 63, tok = tok0 + tl, hm = g >> 3, d0 = (g & 7) * 8; const bf16* r = R + (size_t)tok * NRA; float o[8];
            if (d0 < 16) rope8(r + 2048 + hm * 64, 8, d0, tab + (size_t)tok * 112 + 96, 0.125f * LOG2E, o);
            else { ld8(r + 2048 + hm * 64 + d0, o);
#pragma unroll
                for (int e = 0; e < 8; ++e) o[e] *= 0.125f * LOG2E; }
            st8((bf16*)(P + P_DQ) + (size_t)tok * 512 + g * 8, o);
            if (d0 < 16) rope8(r + 2560 + hm * 64, 8, d0, tab + (size_t)tok * 112 + 96, 1.f, o); else ld8(r + 2560 + hm * 64 + d0, o);
            st8((bf16*)(P + P_DK) + (size_t)tok * 512 + g * 8, o); }
        { const int tok = tok0 + F.lane; const bf16* r = R + (size_t)tok * NRA; const float* tb = tab + (size_t)tok * 112;
            for (int c = F.wave; c < 1792; c += 8) {
                if (c < 256) { const int h = c >> 6, d = c & 63, i = d & 31; const float x1 = bf1(r[256 + h * 64 + i]), x2 = bf1(r[256 + h * 64 + 32 + i]); const float cs = tb[2 * i], sn = tb[2 * i + 1];
                    const float v = (d < 32 ? x1 * cs - x2 * sn : x2 * cs + x1 * sn) * exp2f(a.log2g[h] * (float)(63 - F.lane));
                    ((bf16*)(P + P_RKDT))[((size_t)(b * 4 + h) * 64 + d) * SEQ + s0 + F.lane] = (bf16)(cvtpk(v, 0.f) & 0xffffu); }
                else if (c < 768) { const int cc = c - 256; ((bf16*)(P + P_RVT))[((size_t)b * 512 + cc) * SEQ + s0 + F.lane] = r[512 + cc]; }
                else if (c < 1280) { const int cc = c - 768, h = cc >> 6, e = cc & 63; const float v = bf1(r[4352 + h * 128 + 64 + e]) * rkv[F.lane];
                    ((bf16*)(P + P_MVT))[((size_t)b * 512 + cc) * SEQ + s0 + F.lane] = (bf16)(cvtpk(v, 0.f) & 0xffffu); }
                else { const int cc = c - 1280; ((bf16*)(P + P_DVT))[((size_t)b * 512 + cc) * SEQ + s0 + F.lane] = r[3072 + cc]; }
            } }
        __syncthreads();
    }
}

template <int DK, int DV, int NQG>
__device__ __forceinline__ void attn_core(const bf16* __restrict__ Qp, int ldq, const bf16* __restrict__ Kp, int ldk, const bf16* __restrict__ VTp, int ldv, int nkeys,
                                          f32x4 (&o)[NQG][DV / 16], float (&linv)[NQG], int lane) {
    constexpr int NKS = DK / 32, NDV = DV / 16;
    const int fr = lane & 15, fq = lane >> 4;
    bf16x8 qf[NQG][NKS];
#pragma unroll
    for (int g = 0; g < NQG; ++g)
#pragma unroll
        for (int ks = 0; ks < NKS; ++ks) qf[g][ks] = *(const bf16x8*)(Qp + (size_t)(g * 16 + fr) * ldq + ks * 32 + fq * 8);
    float mrow[NQG], lrow[NQG];
#pragma unroll
    for (int g = 0; g < NQG; ++g) { mrow[g] = -1e30f; lrow[g] = 0.f;
#pragma unroll
        for (int d = 0; d < NDV; ++d) o[g][d] = (f32x4){0.f, 0.f, 0.f, 0.f}; }
    const bf16* kbase = Kp + (size_t)fr * ldk + fq * 8;
    const bf16* vbase = VTp + (size_t)fr * ldv + fq * 4;
    for (int kt = 0; kt < nkeys; kt += 64) {
        f32x4 s[NQG][4];
#pragma unroll
        for (int kb = 0; kb < 4; ++kb) {
            bf16x8 kf[NKS];
#pragma unroll
            for (int ks = 0; ks < NKS; ++ks) kf[ks] = *(const bf16x8*)(kbase + (size_t)(kt + kb * 16) * ldk + ks * 32);
#pragma unroll
            for (int g = 0; g < NQG; ++g) { f32x4 c = (f32x4){0.f, 0.f, 0.f, 0.f};
#pragma unroll
                for (int ks = 0; ks < NKS; ++ks) c = __builtin_amdgcn_mfma_f32_16x16x32_bf16(kf[ks], qf[g][ks], c, 0, 0, 0);
                s[g][kb] = c; }
        }
        bf16x8 pb[NQG][2];
#pragma unroll
        for (int g = 0; g < NQG; ++g) {
            float mx = fmaxf(fmaxf(s[g][0][0], s[g][0][1]), fmaxf(s[g][0][2], s[g][0][3]));
#pragma unroll
            for (int kb = 1; kb < 4; ++kb) mx = fmaxf(mx, fmaxf(fmaxf(s[g][kb][0], s[g][kb][1]), fmaxf(s[g][kb][2], s[g][kb][3])));
            mx = fmaxf(mx, __shfl_xor(mx, 16)); mx = fmaxf(mx, __shfl_xor(mx, 32));
            const float mn = fmaxf(mrow[g], mx), alpha = __builtin_amdgcn_exp2f(mrow[g] - mn); mrow[g] = mn;
            float ps = 0.f; float p[4][4];
#pragma unroll
            for (int kb = 0; kb < 4; ++kb)
#pragma unroll
                for (int j = 0; j < 4; ++j) { p[kb][j] = __builtin_amdgcn_exp2f(s[g][kb][j] - mn); ps += p[kb][j]; }
            lrow[g] = lrow[g] * alpha + ps;
#pragma unroll
            for (int d = 0; d < NDV; ++d) o[g][d] = o[g][d] * alpha;
#pragma unroll
            for (int kg = 0; kg < 2; ++kg) { v4u w; w.x = cvtpk(p[2 * kg][0], p[2 * kg][1]); w.y = cvtpk(p[2 * kg][2], p[2 * kg][3]); w.z = cvtpk(p[2 * kg + 1][0], p[2 * kg + 1][1]); w.w = cvtpk(p[2 * kg + 1][2], p[2 * kg + 1][3]);
                pb[g][kg] = __builtin_bit_cast(bf16x8, w); }
        }
#pragma unroll
        for (int kg = 0; kg < 2; ++kg)
#pragma unroll
            for (int d = 0; d < NDV; ++d) {
                const bf16* vp = vbase + (size_t)(d * 16) * ldv + kt + kg * 32;
                const u32x2 lo = *(const u32x2*)vp, hi = *(const u32x2*)(vp + 16);
                v4u w; w.x = lo.x; w.y = lo.y; w.z = hi.x; w.w = hi.y; const bf16x8 vf = __builtin_bit_cast(bf16x8, w);
#pragma unroll
                for (int g = 0; g < NQG; ++g) o[g][d] = __builtin_amdgcn_mfma_f32_16x16x32_bf16(vf, pb[g][kg], o[g][d], 0, 0, 0);
            }
    }
#pragma unroll
    for (int g = 0; g < NQG; ++g) { float l = lrow[g]; l += __shfl_xor(l, 16); l += __shfl_xor(l, 32); linv[g] = 1.0f / l; }
}

__device__ __forceinline__ void mla_unit(Frame& F, int b, int h, int qb) {
    int lane_ = F.lane; asm volatile("" : "+v"(lane_));
    unsigned char* P = F.ws + WS_PREP; const int q0 = b * SEQ + qb * 32, nkeys = ((qb >> 1) + 1) * 64;
    f32x4 o[2][4]; float linv[2];
    attn_core<96, 64, 2>((const bf16*)(P + P_MQ) + (size_t)q0 * 768 + h * 96, 768, (const bf16*)(P + P_MK) + (size_t)b * SEQ * 768 + h * 96, 768,
                         (const bf16*)(P + P_MVT) + (size_t)(b * 8 + h) * 64 * SEQ, SEQ, nkeys, o, linv, lane_);
    const int fr = lane_ & 15, fq = lane_ >> 4; bf16* Y = (bf16*)(F.ws + WS_YBR) + (size_t)1 * M * 512;
#pragma unroll
    for (int g = 0; g < 2; ++g)
#pragma unroll
        for (int d = 0; d < 4; ++d) { const f32x4 v = o[g][d] * linv[g]; u32x2 w; w.x = cvtpk(v[0], v[1]); w.y = cvtpk(v[2], v[3]);
            *(u32x2*)(Y + (size_t)(q0 + g * 16 + fr) * 512 + h * 64 + d * 16 + fq * 4) = w; }
}
__device__ __forceinline__ void diff_unit(Frame& F, const Args& a, int l, int b, int h, int qb) {
    int lane_ = F.lane; asm volatile("" : "+v"(lane_));
    unsigned char* P = F.ws + WS_PREP; const int q0 = b * SEQ + qb * 32, nkeys = ((qb >> 1) + 1) * 64;
    const float lam_init = a.lam_init[l], lam = ((const float*)(F.ctl + CW_LAM))[l];
    LAS float* stash = (LAS float*)(F.lds + F.wave * 16384) + lane_;
    f32x4 o[2][8]; float linv[2];
    for (int map = 0; map < 2; ++map) {
        attn_core<64, 128, 2>((const bf16*)(P + P_DQ) + (size_t)q0 * 512 + (h * 2 + map) * 64, 512, (const bf16*)(P + P_DK) + (size_t)b * SEQ * 512 + (h * 2 + map) * 64, 512,
                              (const bf16*)(P + P_DVT) + (size_t)(b * 4 + h) * 128 * SEQ, SEQ, nkeys, o, linv, lane_);
        if (map == 0) {
#pragma unroll
            for (int g = 0; g < 2; ++g)
#pragma unroll
                for (int d = 0; d < 8; ++d)
#pragma unroll
                    for (int j = 0; j < 4; ++j) stash[((g * 8 + d) * 4 + j) * 64] = o[g][d][j] * linv[g];
        }
    }
    const int fr = lane_ & 15, fq = lane_ >> 4; bf16* Y = (bf16*)(F.ws + WS_YBR) + (size_t)2 * M * 512;
#pragma unroll
    for (int g = 0; g < 2; ++g) { float ss = 0.f;
#pragma unroll
        for (int d = 0; d < 8; ++d)
#pragma unroll
            for (int j = 0; j < 4; ++j) { const float v = stash[((g * 8 + d) * 4 + j) * 64] - lam * o[g][d][j] * linv[g]; o[g][d][j] = v; ss += v * v; }
        ss += __shfl_xor(ss, 16); ss += __shfl_xor(ss, 32);
        const float rs = rsqrtf(ss * (1.f / 128.f) + EPS) * (1.f - lam_init);
#pragma unroll
        for (int d = 0; d < 8; ++d) { const f32x4 v = o[g][d] * rs; u32x2 w; w.x = cvtpk(v[0], v[1]); w.y = cvtpk(v[2], v[3]);
            *(u32x2*)(Y + (size_t)(q0 + g * 16 + fr) * 512 + h * 128 + d * 16 + fq * 4) = w; } }
}
__device__ __forceinline__ void cross_unit(Frame& F, int l, int b, int h, int qb, int half) {
    int lane_ = F.lane; asm volatile("" : "+v"(lane_));
    const int q0 = b * SEQ + qb * 16;
    f32x4 o[1][8]; float linv[1];
    attn_core<256, 128, 1>((const bf16*)(F.ws + WS_CQ) + (size_t)q0 * DM + h * 256, DM, (const bf16*)(F.ws + WS_CK) + ((size_t)l * 2048 + b * 256) * DM + h * 256, DM,
                           (const bf16*)(F.ws + WS_CVT) + (size_t)l * 2048 * DM + ((size_t)(b * 4 + h) * 256 + half * 128) * 256, 256, 256, o, linv, lane_);
    const int fr = lane_ & 15, fq = lane_ >> 4; bf16* O = (bf16*)(F.ws + WS_CO);
#pragma unroll
    for (int d = 0; d < 8; ++d) { const f32x4 v = o[0][d] * linv[0]; u32x2 w; w.x = cvtpk(v[0], v[1]); w.y = cvtpk(v[2], v[3]);
        *(u32x2*)(O + (size_t)(q0 + fr) * DM + h * 256 + half * 128 + d * 16 + fq * 4) = w; }
}
__device__ __forceinline__ void ret_kv_unit(Frame& F, int b, int c, int h) {
    int lane_ = F.lane; asm volatile("" : "+v"(lane_));
    unsigned char* P = F.ws + WS_PREP; const int fr = lane_ & 15, fq = lane_ >> 4;
    const bf16* kd = (const bf16*)(P + P_RKDT) + (size_t)(b * 4 + h) * 64 * SEQ + c * 64;
    const bf16* vt = (const bf16*)(P + P_RVT) + (size_t)(b * 4 + h) * 128 * SEQ + c * 64;
    float* out = (float*)(F.ws + WS_KVC) + (size_t)((b * 32 + c) * 4 + h) * 8192;
    bf16x8 af[4][2];
#pragma unroll
    for (int db = 0; db < 4; ++db)
#pragma unroll
        for (int ks = 0; ks < 2; ++ks) af[db][ks] = *(const bf16x8*)(kd + (size_t)(db * 16 + fr) * SEQ + ks * 32 + fq * 8);
#pragma unroll
    for (int eb = 0; eb < 8; ++eb) { bf16x8 bfv[2];
#pragma unroll
        for (int ks = 0; ks < 2; ++ks) bfv[ks] = *(const bf16x8*)(vt + (size_t)(eb * 16 + fr) * SEQ + ks * 32 + fq * 8);
#pragma unroll
        for (int db = 0; db < 4; ++db) { f32x4 cacc = (f32x4){0.f, 0.f, 0.f, 0.f};
#pragma unroll
            for (int ks = 0; ks < 2; ++ks) cacc = __builtin_amdgcn_mfma_f32_16x16x32_bf16(af[db][ks], bfv[ks], cacc, 0, 0, 0);
            *(f32x4*)(out + (size_t)(eb * 16 + fr) * 64 + db * 16 + fq * 4) = cacc; } }
}
__device__ __forceinline__ void ret_scan_phase(Frame& F, const Args& a) {
    float* kvc = (float*)(F.ws + WS_KVC);
    for (int e = blockIdx.x * 512 + F.tid; e < NB * 4 * 8192; e += F.G * 512) {
        const int b = e / (4 * 8192), h = (e / 8192) & 3, idx = e & 8191; const float dec = exp2f(a.log2g[h] * 64.f); float st = 0.f;
        float* p = kvc + (size_t)(b * 32 * 4 + h) * 8192 + idx;
#pragma unroll 4
        for (int c = 0; c < 32; ++c) { const float kv = p[(size_t)c * 4 * 8192]; p[(size_t)c * 4 * 8192] = st; st = st * dec + kv; }
    }
}
__device__ __forceinline__ void ret_out_unit(Frame& F, const Args& a, int b, int c, int h, int half) {
    int lane_ = F.lane; asm volatile("" : "+v"(lane_));
    unsigned char* P = F.ws + WS_PREP; const int fr = lane_ & 15, fq = lane_ >> 4; const int t0 = b * SEQ + c * 64; const float l2g = a.log2g[h];
    const bf16* Qp = (const bf16*)(P + P_RQ) + (size_t)(t0 + half * 32) * 256 + h * 64;
    const bf16* Kp = (const bf16*)(P + P_RK) + (size_t)t0 * 256 + h * 64;
    const bf16* vt = (const bf16*)(P + P_RVT) + (size_t)(b * 4 + h) * 128 * SEQ + c * 64;
    const float* st = (const float*)(F.ws + WS_KVC) + (size_t)((b * 32 + c) * 4 + h) * 8192;
    bf16x8 qf[2][2];
#pragma unroll
    for (int g = 0; g < 2; ++g)
#pragma unroll
        for (int ks = 0; ks < 2; ++ks) qf[g][ks] = *(const bf16x8*)(Qp + (size_t)(g * 16 + fr) * 256 + ks * 32 + fq * 8);
    bf16x8 pb[2][2];
    {
        f32x4 s[2][4];
#pragma unroll
        for (int kb = 0; kb < 4; ++kb) { bf16x8 kf[2];
#pragma unroll
            for (int ks = 0; ks < 2; ++ks) kf[ks] = *(const bf16x8*)(Kp + (size_t)(kb * 16 + fr) * 256 + ks * 32 + fq * 8);
#pragma unroll
            for (int g = 0; g < 2; ++g) { f32x4 cacc = (f32x4){0.f, 0.f, 0.f, 0.f};
#pragma unroll
                for (int ks = 0; ks < 2; ++ks) cacc = __builtin_amdgcn_mfma_f32_16x16x32_bf16(kf[ks], qf[g][ks], cacc, 0, 0, 0);
                s[g][kb] = cacc; } }
#pragma unroll
        for (int g = 0; g < 2; ++g) { const int n = half * 32 + g * 16 + fr; float p[4][4];
#pragma unroll
            for (int kb = 0; kb < 4; ++kb)
#pragma unroll
                for (int j = 0; j < 4; ++j) { const int mk = kb * 16 + fq * 4 + j; const int dd = n > mk ? n - mk : mk - n; p[kb][j] = s[g][kb][j] * exp2f(l2g * (float)dd); }
#pragma unroll
            for (int kg = 0; kg < 2; ++kg) { v4u w; w.x = cvtpk(p[2 * kg][0], p[2 * kg][1]); w.y = cvtpk(p[2 * kg][2], p[2 * kg][3]); w.z = cvtpk(p[2 * kg + 1][0], p[2 * kg + 1][1]); w.w = cvtpk(p[2 * kg + 1][2], p[2 * kg + 1][3]);
                pb[g][kg] = __builtin_bit_cast(bf16x8, w); } }
    }
    f32x4 o[2][8];
#pragma unroll
    for (int d = 0; d < 8; ++d) {
        f32x4 x[2] = {(f32x4){0.f, 0.f, 0.f, 0.f}, (f32x4){0.f, 0.f, 0.f, 0.f}};
#pragma unroll
        for (int ks = 0; ks < 2; ++ks) { const float* sp = st + (size_t)(d * 16 + fr) * 64 + ks * 32 + fq * 8; const f32x4 s0 = *(const f32x4*)sp, s1 = *(const f32x4*)(sp + 4);
            v4u w; w.x = cvtpk(s0[0], s0[1]); w.y = cvtpk(s0[2], s0[3]); w.z = cvtpk(s1[0], s1[1]); w.w = cvtpk(s1[2], s1[3]); const bf16x8 sf = __builtin_bit_cast(bf16x8, w);
#pragma unroll
            for (int g = 0; g < 2; ++g) x[g] = __builtin_amdgcn_mfma_f32_16x16x32_bf16(sf, qf[g][ks], x[g], 0, 0, 0); }
#pragma unroll
        for (int g = 0; g < 2; ++g) { const int n = half * 32 + g * 16 + fr; o[g][d] = x[g] * exp2f(l2g * (float)(n + 1)); }
#pragma unroll
        for (int kg = 0; kg < 2; ++kg) { const bf16* vp = vt + (size_t)(d * 16 + fr) * SEQ + kg * 32 + fq * 4; const u32x2 lo = *(const u32x2*)vp, hi = *(const u32x2*)(vp + 16);
            v4u w; w.x = lo.x; w.y = lo.y; w.z = hi.x; w.w = hi.y; const bf16x8 vf = __builtin_bit_cast(bf16x8, w);
#pragma unroll
            for (int g = 0; g < 2; ++g) o[g][d] = __builtin_amdgcn_mfma_f32_16x16x32_bf16(vf, pb[g][kg], o[g][d], 0, 0, 0); }
    }
    const bf16* R = (const bf16*)(F.ws + WS_RA); bf16* Y = (bf16*)(F.ws + WS_YBR);
#pragma unroll
    for (int g = 0; g < 2; ++g) { float ss = 0.f;
#pragma unroll
        for (int d = 0; d < 8; ++d) ss += (o[g][d][0] * o[g][d][0] + o[g][d][1] * o[g][d][1]) + (o[g][d][2] * o[g][d][2] + o[g][d][3] * o[g][d][3]);
        ss += __shfl_xor(ss, 16); ss += __shfl_xor(ss, 32);
        const float rs = rsqrtf(ss * (1.f / 128.f) + EPS); const size_t tok = (size_t)(t0 + half * 32 + g * 16 + fr);
#pragma unroll
        for (int d = 0; d < 8; ++d) { const u32x2 gw = *(const u32x2*)(R + tok * NRA + 1024 + h * 128 + d * 16 + fq * 4);
            const float g0 = bflo(gw.x), g1 = bfhi(gw.x), g2 = bflo(gw.y), g3 = bfhi(gw.y);
            const float v0 = o[g][d][0] * rs * g0 * pg8::sigmoidf_(g0), v1 = o[g][d][1] * rs * g1 * pg8::sigmoidf_(g1), v2 = o[g][d][2] * rs * g2 * pg8::sigmoidf_(g2), v3 = o[g][d][3] * rs * g3 * pg8::sigmoidf_(g3);
            u32x2 w; w.x = cvtpk(v0, v1); w.y = cvtpk(v2, v3); *(u32x2*)(Y + tok * 512 + h * 128 + d * 16 + fq * 4) = w; } }
}

#ifndef MK_LAST_PHASE
#define MK_LAST_PHASE (1 + 18 * 4)
#endif
constexpr int PH_PER_LAYER = 18, N_PHASES = MK_LAST_PHASE;
template <int MODE>
__device__ __forceinline__ void run_static_gemm(Frame& F, const bf16* A, const bf16* Bt, int N, int K, void* O, const void* aux, int ldc) {
    pg8::Gemm g{A, Bt, M, N, K}; pg8::StaticOrder S; S.init(M, N, F.G, (int)blockIdx.x);
    pg8::EpiX<MODE> E{O, aux, ldc};
    pg8::gemm_phase<pg8::EpiX<MODE>, pg8::StaticOrder, true, true>(F.lds, g, S, E, F.wave);
}

__global__ void __launch_bounds__(NWAVES * 64, 2) mk_fwd(Args a_) {
    extern __shared__ __attribute__((aligned(16))) unsigned char lds_raw[];
    {
        LAS unsigned char* l0 = (LAS unsigned char*)lds_raw;
        for (int u = threadIdx.x; u < (LDS_BYTES - LDSCTL_OFF) / 4; u += NWAVES * 64) ((LAS unsigned*)(l0 + LDSCTL_OFF))[u] = 0u;
        __syncthreads();
    }
    if (a_.ph_lo == 0 && blockIdx.x == 0) { unsigned* c0 = (unsigned*)(a_.ws + WS_CTL); for (int u = threadIdx.x; u < 32768; u += NWAVES * 64) __hip_atomic_store(c0 + u, 0u, __ATOMIC_RELAXED, __HIP_MEMORY_SCOPE_AGENT); __threadfence(); }
#if !MK_PER_PHASE
    cg::this_grid().sync();
    XcdBarrier bar = xcd_barrier_post((unsigned*)(a_.ws + WS_CTL) + CW_BAR, (volatile LAS unsigned*)((LAS unsigned char*)lds_raw + MISC_OFF) + 8);
#endif
    const int ph_lo = a_.ph_lo, ph_hi = a_.ph_hi; const int wave0 = __builtin_amdgcn_readfirstlane((int)threadIdx.x >> 6);
    for (int ph = ph_lo; ph < ph_hi; ++ph) {
        const __attribute__((address_space(4))) Args* ap4 = (const __attribute__((address_space(4))) Args*)__builtin_amdgcn_kernarg_segment_ptr();
        asm volatile("" : "+s"(ap4));
        const Args& a = *(const Args*)ap4;
        Frame F;
        F.lds = (LAS unsigned char*)lds_raw; F.MISC = (volatile LAS unsigned*)(F.lds + MISC_OFF);
        { int w_ = wave0; asm volatile("" : "+s"(w_)); int l_ = (int)__builtin_amdgcn_mbcnt_hi(~0u, __builtin_amdgcn_mbcnt_lo(~0u, 0u)); asm volatile("" : "+v"(l_)); F.wave = w_; F.lane = l_; F.tid = w_ * 64 + l_; }
        F.G = gridDim.x; F.gw = blockIdx.x * NWAVES + F.wave; F.NGW = F.G * NWAVES; F.ws = a.ws; F.ctl = (unsigned*)(a.ws + WS_CTL);
        unsigned char* ws = a.ws; unsigned char* wb = ws + WS_W; float* x = a.out;
        bf16* XB = (bf16*)(ws + WS_XB);
        if (ph == 0) {
            init_phase(F, a);
            ew_phase(F, a.in[0], nullptr, nullptr, 0.f, a.in[3], x, XB);
            wconv_layer(F, a, 0);
        } else {
            const int l = (ph - 1) / PH_PER_LAYER, j = (ph - 1) % PH_PER_LAYER;
            const float* n_ffn1 = a.in[3] + (size_t)l * 2 * DM; const float* n_mix = a.in[6] + (size_t)l * 2 * DM; const float* n_cross = a.in[15] + (size_t)l * 3 * DM; const float* n_ffn2 = a.in[19] + (size_t)l * 2 * DM;
            if (j == 0 || j == 15) {
                if (j == 0 && l == 0) {
                    pg8::Gemm g{(const bf16*)(ws + WS_T_MEMN), (const bf16*)(ws + WS_T_WKV), 8192, 8192, DM}; pg8::CkvOrder S{F.G, (int)blockIdx.x};
                    pg8::EpiX<5> E{(void*)(ws + WS_CK), (const void*)(ws + WS_CVT), DM};
                    pg8::gemm_phase<pg8::EpiX<5>, pg8::CkvOrder, true, true>(F.lds, g, S, E, F.wave);
                }
                run_static_gemm<1>(F, XB, (const bf16*)(wb + (j == 0 ? W_13A : W_13B)), 2 * DFF, DM, (void*)(ws + WS_ACT), nullptr, DFF);
            } else if (j == 1 || j == 16 || j == 9 || j == 13) {
                const bf16* A = (j == 1 || j == 16) ? (const bf16*)(ws + WS_ACT) : (j == 9 ? (const bf16*)(ws + WS_Z) : (const bf16*)(ws + WS_CO));
                const bf16* Bt = (const bf16*)(wb + (j == 1 ? W_2A : j == 16 ? W_2B : j == 9 ? W_OUT : W_CO));
                run_static_gemm<2>(F, A, Bt, DM, (j == 1 || j == 16) ? DFF : DM, (void*)(ws + WS_Y), nullptr, DM);
            } else if (j == 2 || j == 10 || j == 14 || j == 17) {
                const float* gpost = j == 2 ? n_ffn1 + DM : j == 10 ? n_mix + DM : j == 14 ? n_cross + DM : n_ffn2 + DM;
                const float* gpre = j == 2 ? n_mix : j == 10 ? n_cross : j == 14 ? n_ffn2 : (l + 1 < DEPTH ? a.in[3] + (size_t)(l + 1) * 2 * DM : nullptr);
                ew_phase(F, x, (const float*)(ws + WS_Y), gpost, (j == 2 || j == 17) ? 0.5f : 1.0f, gpre, x, XB);
                if (j == 17 && l + 1 < DEPTH) wconv_layer(F, a, l + 1);
            } else if (j == 3 || j == 11) {
                if (j == 3) run_static_gemm<0>(F, XB, (const bf16*)(wb + W_IN), NRA, DM, (void*)(ws + WS_RA), nullptr, NRA);
                else run_static_gemm<0>(F, XB, (const bf16*)(wb + W_CQ), DM, DM, (void*)(ws + WS_CQ), nullptr, DM);
            } else if (j == 4) {
                prep_phase(F, a);
            } else if (j == 5) {
                unsigned* ctr = F.ctl + CW_WQ + 64 * (l * 4 + 0);
                for (;;) { const unsigned u = wq_next(ctr, F.lane); if (u >= 2048u + 4096u + 1024u) break;
                    if (u < 2048u) { const int qb = 63 - (int)(u >> 5), bh = u & 31; diff_unit(F, a, l, bh >> 2, bh & 3, qb); }
                    else if (u < 6144u) { const unsigned v = u - 2048u; const int qb = 63 - (int)(v >> 6), bh = v & 63; mla_unit(F, bh >> 3, bh & 7, qb); }
                    else { const unsigned v = u - 6144u; ret_kv_unit(F, v >> 7, (v >> 2) & 31, v & 3); } }
            } else if (j == 6) {
                ret_scan_phase(F, a);
                run_static_gemm<3>(F, XB, (const bf16*)(wb + W_IN) + (size_t)NRA * DM, 3072, DM, (void*)(ws + WS_G), nullptr, 3072);
            } else if (j == 7) {
                unsigned* ctr = F.ctl + CW_WQ + 64 * (l * 4 + 1);
                for (;;) { const unsigned u = wq_next(ctr, F.lane); if (u >= 2048u) break; ret_out_unit(F, a, u >> 8, (u >> 3) & 31, (u >> 1) & 3, u & 1); }
            } else if (j == 8) {
                pg8::Gemm g{(const bf16*)(ws + WS_YBR), (const bf16*)(wb + W_BR), 3 * M, 3 * DM, 512}; pg8::BranchOrder S{F.G, (int)blockIdx.x};
                pg8::EpiX<4> E{(void*)(ws + WS_Z), (const void*)(ws + WS_G), DM};
                pg8::gemm_phase<pg8::EpiX<4>, pg8::BranchOrder, true, true>(F.lds, g, S, E, F.wave);
            } else {
                unsigned* ctr = F.ctl + CW_WQ + 64 * (l * 4 + 2);
                for (;;) { const unsigned u = wq_next(ctr, F.lane); if (u >= 8192u) break; const int bh = u >> 8; cross_unit(F, l, bh >> 2, bh & 3, (u >> 1) & 127, u & 1); }
            }
        }
#if !MK_PER_PHASE
        if (ph + 1 < ph_hi) xcd_barrier(bar);
#endif
    }
}

extern "C" void kernel_launch(void* const* d_in, const int* in_sizes, int n_in, void* d_out, int out_size, void* d_ws, size_t ws_size, hipStream_t stream) {
    static int grid = 0;
    if (grid == 0) {
        if (n_in != 22 || out_size != M * DM || ws_size < WS_END) { fprintf(stderr, "kernel_launch: unexpected shapes (n_in %d, out %d, ws %zu)\n", n_in, out_size, ws_size); grid = -1; return; }
        int dev = 0, cus = 0;
        hipGetDevice(&dev); hipDeviceGetAttribute(&cus, hipDeviceAttributeMultiprocessorCount, dev);
        if (hipFuncSetAttribute((const void*)mk_fwd, hipFuncAttributeMaxDynamicSharedMemorySize, LDS_BYTES) != hipSuccess) { fprintf(stderr, "kernel_launch: hipFuncSetAttribute failed\n"); grid = -1; return; }
        int per_cu = 0;
        if (hipOccupancyMaxActiveBlocksPerMultiprocessor(&per_cu, (const void*)mk_fwd, NWAVES * 64, LDS_BYTES) != hipSuccess || per_cu < 1) { fprintf(stderr, "kernel_launch: occupancy query says %d\n", per_cu); (void)hipGetLastError(); }
        grid = cus;
    }
    if (grid < 0) return;
    hipMemsetAsync((char*)d_ws + WS_CTL, 0, CTL_BYTES, stream);
    Args a; memset(&a, 0, sizeof(a));
    for (int i = 0; i < 22; ++i) a.in[i] = (const float*)d_in[i];
    a.out = (float*)d_out; a.ws = (unsigned char*)d_ws;
    for (int i = 0; i < 32; ++i) a.inv_freq[i] = (float)(1.0 / pow(10000.0, (double)(2 * i) / 64.0));
    for (int i = 0; i < 16; ++i) a.inv_freq[32 + i] = (float)(1.0 / pow(500000.0, (double)(2 * i) / 32.0));
    for (int i = 0; i < 8; ++i) a.inv_freq[48 + i] = (float)(1.0 / pow(500000.0, (double)(2 * i) / 16.0));
    for (int l = 0; l < 4; ++l) { a.lam_init[l] = (float)(0.8 - 0.6 * exp(-0.3 * l)); a.log2g[l] = (float)log2(1.0 - pow(2.0, -5.0 - l)); }
#if MK_PER_PHASE
    for (int ph = 0; ph < N_PHASES; ++ph) { a.ph_lo = ph; a.ph_hi = ph + 1; hipLaunchKernelGGL(mk_fwd, dim3(grid), dim3(NWAVES * 64), LDS_BYTES, stream, a); }
#else
    a.ph_lo = 0; a.ph_hi = N_PHASES;
    void* args[] = {&a};
    hipError_t e = hipLaunchCooperativeKernel((const void*)mk_fwd, dim3(grid), dim3(NWAVES * 64), args, LDS_BYTES, stream);
    if (e != hipSuccess) fprintf(stderr, "cooperative launch failed: %s (grid %d)\n", hipGetErrorString(e), grid);
#endif
}
```

```cpp
#include <hip/hip_runtime.h>
#include <hip/hip_cooperative_groups.h>
#include <cstdio>
#include <cstdint>
#include <cstring>
#include <cmath>
namespace cg = cooperative_groups;
namespace pg8 {
#define PG8_LAS __attribute__((address_space(3)))
typedef unsigned short bf16_t;
typedef short bf16x8 __attribute__((ext_vector_type(8)));
typedef float f32x4 __attribute__((ext_vector_type(4)));
typedef unsigned u32x4 __attribute__((ext_vector_type(4)));
constexpr int BM = 256, BK = 64, HALF = 128, HTB = HALF * BK * 2  , STAGE_BYTES = 8 * HTB, NXCD = 8, WGM = 8;

__host__ __device__ __forceinline__ int lds_byte(int r, int c) { const int st = (r >> 4) * 2 + (c >> 5), rr = r & 15, cc = c & 31, ob = rr * 64 + cc * 2; return st * 1024 + (ob ^ (((ob >> 9) & 1) << 5)); }
__host__ __device__ __forceinline__ void stage_rc(int b, int& R, int& C) { const int st = b / 1024, sb = b % 1024, swz = sb ^ (((sb >> 9) & 1) << 5); R = (st >> 1) * 16 + swz / 64; C = (st & 1) * 32 + (swz % 64) / 2; }
__host__ __device__ __forceinline__ int perm32(int rho) { const int n = rho >> 4, i = rho & 15; return 8 * (i >> 2) + 4 * n + (i & 3); }

struct Unit { int pm, pn; };
struct Gemm { const bf16_t* A; const bf16_t* Bt; int M, N, K; };

struct StaticOrder {
    int nM, nN, nwg, G, c;
    __host__ __device__ void init(int M, int N, int G_, int c_) { nM = M / BM; nN = N / BM; nwg = nM * nN; G = G_; c = c_; }
    __host__ __device__ bool next(int i, Unit& u) const {
        const long L = (long)i * G + c; if (L >= nwg) return false;
        int wgid = (int)L; { const int q = nwg / NXCD, r = nwg % NXCD, xcd = wgid % NXCD, off = wgid / NXCD; wgid = (xcd < r ? xcd * (q + 1) : r * (q + 1) + (xcd - r) * q) + off; }
        const int nig = WGM * nN, gid = wgid / nig, fm = gid * WGM, gsz = (nM - fm) < WGM ? (nM - fm) : WGM;
        u.pm = fm + ((wgid % nig) % gsz); u.pn = (wgid % nig) / gsz; return true;
    }
    __device__ __forceinline__ void a_ready(const Unit&) const {}
    __device__ __forceinline__ void done(const Unit&) const {}
};
typedef float f32x2_cv __attribute__((ext_vector_type(2))); typedef __bf16 bf16x2_cv __attribute__((ext_vector_type(2)));
__device__ __forceinline__ unsigned cvt_pk_bf16(float lo, float hi) { f32x2_cv v = {lo, hi}; bf16x2_cv b = __builtin_convertvector(v, bf16x2_cv); return __builtin_bit_cast(unsigned, b); }
typedef float f32x2 __attribute__((ext_vector_type(2)));

typedef unsigned u32x2 __attribute__((ext_vector_type(2)));
__device__ __forceinline__ float sigmoidf_(float x) { return 1.0f / (1.0f + __expf(-x)); }
__device__ __forceinline__ float bf_lo(unsigned w) { return __uint_as_float(w << 16); }
__device__ __forceinline__ float bf_hi(unsigned w) { return __uint_as_float(w & 0xffff0000u); }
template <int MODE> struct EpiX {
    static constexpr bool PERM = true, AFTER_DRAIN = false;
    void* O; const void* aux; int ldc;
    __device__ __forceinline__ void operator()(const f32x4 (&acc)[2][2][4][2], const Unit& u, int wr, int wc, int fr, int fq) const {
        int pm = u.pm, pn = u.pn, bsel = 0;
        if (MODE == 4) { bsel = pm >> 6; pm &= 63; pn &= 3; }
        if (MODE == 5) { bsel = pm >> 3; pm &= 7; pn &= 7; }
        const int row0 = pm * BM + wr * 64 + fr, col0 = pn * BM + wc * 32 + 8 * fq;
#pragma unroll
        for (int ai = 0; ai < 2; ++ai)
#pragma unroll
            for (int m = 0; m < 4; ++m) {
                const size_t row = (size_t)(row0 + ai * HALF + m * 16);
#pragma unroll
                for (int bj = 0; bj < 2; ++bj) {
                    const f32x4 v0 = acc[ai][bj][m][0], v1 = acc[ai][bj][m][1];
                    const int col = col0 + bj * HALF;
                    if (MODE == 0) {
                        u32x4 w; w.x = cvt_pk_bf16(v0[0], v0[1]); w.y = cvt_pk_bf16(v0[2], v0[3]); w.z = cvt_pk_bf16(v1[0], v1[1]); w.w = cvt_pk_bf16(v1[2], v1[3]);
                        *(u32x4*)((bf16_t*)O + row * ldc + col) = w;
                    } else if (MODE == 1) {
                        float r0 = v0[0] * sigmoidf_(v0[0]) * v1[0], r1 = v0[1] * sigmoidf_(v0[1]) * v1[1], r2 = v0[2] * sigmoidf_(v0[2]) * v1[2], r3 = v0[3] * sigmoidf_(v0[3]) * v1[3];
                        u32x2 w; w.x = cvt_pk_bf16(r0, r1); w.y = cvt_pk_bf16(r2, r3);
                        *(u32x2*)((bf16_t*)O + row * ldc + (col >> 1)) = w;
                    } else if (MODE == 2) {
                        float* p = (float*)O + row * ldc + col; *(f32x4*)p = v0; *(f32x4*)(p + 4) = v1;
                    } else if (MODE == 3) {
                        u32x4 w; w.x = cvt_pk_bf16(sigmoidf_(v0[0]), sigmoidf_(v0[1])); w.y = cvt_pk_bf16(sigmoidf_(v0[2]), sigmoidf_(v0[3]));
                        w.z = cvt_pk_bf16(sigmoidf_(v1[0]), sigmoidf_(v1[1])); w.w = cvt_pk_bf16(sigmoidf_(v1[2]), sigmoidf_(v1[3]));
                        *(u32x4*)((bf16_t*)O + row * ldc + col) = w;
                    } else if (MODE == 4) {
                        const u32x4 gw = *(const u32x4*)((const bf16_t*)aux + row * 3072 + bsel * 1024 + col);
                        bf16_t* zp = (bf16_t*)O + row * 1024 + col;
                        float z0 = 0.f, z1 = 0.f, z2 = 0.f, z3 = 0.f, z4 = 0.f, z5 = 0.f, z6 = 0.f, z7 = 0.f;
                        if (bsel != 0) { const u32x4 zw = *(const u32x4*)zp; z0 = bf_lo(zw.x); z1 = bf_hi(zw.x); z2 = bf_lo(zw.y); z3 = bf_hi(zw.y); z4 = bf_lo(zw.z); z5 = bf_hi(zw.z); z6 = bf_lo(zw.w); z7 = bf_hi(zw.w); }
                        z0 += bf_lo(gw.x) * v0[0]; z1 += bf_hi(gw.x) * v0[1]; z2 += bf_lo(gw.y) * v0[2]; z3 += bf_hi(gw.y) * v0[3];
                        z4 += bf_lo(gw.z) * v1[0]; z5 += bf_hi(gw.z) * v1[1]; z6 += bf_lo(gw.w) * v1[2]; z7 += bf_hi(gw.w) * v1[3];
                        u32x4 w; w.x = cvt_pk_bf16(z0, z1); w.y = cvt_pk_bf16(z2, z3); w.z = cvt_pk_bf16(z4, z5); w.w = cvt_pk_bf16(z6, z7);
                        *(u32x4*)zp = w;
                    } else {
                        if (pn < 4) {
                            u32x4 w; w.x = cvt_pk_bf16(v0[0], v0[1]); w.y = cvt_pk_bf16(v0[2], v0[3]); w.z = cvt_pk_bf16(v1[0], v1[1]); w.w = cvt_pk_bf16(v1[2], v1[3]);
                            *(u32x4*)((bf16_t*)O + (size_t)bsel * 2048 * 1024 + row * 1024 + col) = w;
                        } else {
                            const int key = (int)row & 255, d0 = col & 255, h = pn - 4;
                            bf16_t* vt = (bf16_t*)aux + (size_t)bsel * 2048 * 1024 + ((size_t)((pm * 4 + h) * 256 + d0)) * 256 + key;
                            const unsigned w0 = cvt_pk_bf16(v0[0], v0[1]), w1 = cvt_pk_bf16(v0[2], v0[3]), w2 = cvt_pk_bf16(v1[0], v1[1]), w3 = cvt_pk_bf16(v1[2], v1[3]);
                            vt[0 * 256] = (bf16_t)w0; vt[1 * 256] = (bf16_t)(w0 >> 16); vt[2 * 256] = (bf16_t)w1; vt[3 * 256] = (bf16_t)(w1 >> 16);
                            vt[4 * 256] = (bf16_t)w2; vt[5 * 256] = (bf16_t)(w2 >> 16); vt[6 * 256] = (bf16_t)w3; vt[7 * 256] = (bf16_t)(w3 >> 16);
                        }
                    }
                }
            }
    }
};
struct BranchOrder {
    int G, c;
    __device__ bool next(int i, Unit& u) const { const int b = i % 3, t = (i / 3) * G + c; if (t >= 256) return false; u.pm = b * 64 + (t >> 2); u.pn = b * 4 + (t & 3); return true; }
    __device__ __forceinline__ void a_ready(const Unit&) const {}
    __device__ __forceinline__ void done(const Unit&) const {}
};
struct CkvOrder {
    int G, c;
    __device__ bool next(int i, Unit& u) const { const int t = i * G + c; if (t >= 256) return false; const int l = t >> 6; u.pm = l * 8 + ((t >> 3) & 7); u.pn = l * 8 + (t & 7); return true; }
    __device__ __forceinline__ void a_ready(const Unit&) const {}
    __device__ __forceinline__ void done(const Unit&) const {}
};
template <class Epi, class Sched, bool ALIGN_EPI = false, bool SP2 = false>
__device__ __forceinline__ void gemm_phase(PG8_LAS unsigned char* lds, const Gemm g, const Sched& S, const Epi& E, int wave_id) {
    int tid_ = wave_id * 64 + (int)__builtin_amdgcn_mbcnt_hi(~0u, __builtin_amdgcn_mbcnt_lo(~0u, 0u)); asm volatile("" : "+v"(tid_));
    const int tid = tid_, wid = __builtin_amdgcn_readfirstlane(tid >> 6), lane = tid & 63, wr = wid >> 2, wc = wid & 3, fr = lane & 15, fq = lane >> 4;
    const int K = g.K, nt = K / BK;
    unsigned voffA[2], voffB[2];
#pragma unroll
    for (int i = 0; i < 2; ++i) { int R, C; stage_rc(tid * 16 + i * 8192, R, C); const int Rb = Epi::PERM ? ((R & ~31) + perm32(R & 31)) : R;
        voffA[i] = (unsigned)(R * K + C) * 2u; voffB[i] = (unsigned)(Rb * K + C) * 2u; }
    const size_t kstep = (size_t)(BK * 2);
    const size_t hstep = (size_t)HALF * K * 2;
    const size_t tstep = 2 * hstep;
    const unsigned ldsw = (unsigned)wid * 1024u;
    const int aoff = lds_byte(wr * 64 + fr, fq * 8), boff = lds_byte(wc * 32 + fr, fq * 8);
#define PG8_SA(b, h) (((b) * 2 + (h)) * HTB)
#define PG8_SB(b, h) ((4 + (b) * 2 + (h)) * HTB)
#define PG8_STAGE(bufoff, gbase, voff) do { _Pragma("unroll") for (int _i = 0; _i < 2; ++_i) \
        __builtin_amdgcn_global_load_lds((const unsigned*)((const char*)(gbase) + (voff)[_i]), (PG8_LAS unsigned*)(lds + (bufoff) + ldsw + _i * 8192), 16, 0, 0); } while (0)
#define PG8_LDA(dst, b, h) do { _Pragma("unroll") for (int m = 0; m < 4; ++m) _Pragma("unroll") for (int k = 0; k < 2; ++k) dst[m][k] = *(const PG8_LAS bf16x8*)(lds + PG8_SA(b, h) + aoff + m * 2048 + k * 1024); } while (0)
#define PG8_LDB(dst, b, h) do { _Pragma("unroll") for (int n = 0; n < 2; ++n) _Pragma("unroll") for (int k = 0; k < 2; ++k) dst[n][k] = *(const PG8_LAS bf16x8*)(lds + PG8_SB(b, h) + boff + n * 2048 + k * 1024); } while (0)
#define PG8_MMA(ai, bj, At, Bt) do { __builtin_amdgcn_s_setprio(1); _Pragma("unroll") for (int m = 0; m < 4; ++m) _Pragma("unroll") for (int n = 0; n < 2; ++n) _Pragma("unroll") for (int k = 0; k < 2; ++k) \
        acc[ai][bj][m][n] = __builtin_amdgcn_mfma_f32_16x16x32_bf16(Bt[n][k], At[m][k], acc[ai][bj][m][n], 0, 0, 0); __builtin_amdgcn_s_setprio(0); } while (0)
#define PG8_WAIT_V(n) asm volatile("s_waitcnt vmcnt(" #n ")" ::: "memory")
#define PG8_WAIT_L(n) asm volatile("s_waitcnt lgkmcnt(" #n ")" ::: "memory")
#define PG8_BAR __builtin_amdgcn_s_barrier()
#define PG8_SCHED __builtin_amdgcn_sched_barrier(0)
    Unit cur, nxt; int ui = 0;
    if (!S.next(0, cur)) return;
    f32x4 acc[2][2][4][2];
#pragma unroll
    for (int a = 0; a < 2; ++a)
#pragma unroll
        for (int b = 0; b < 2; ++b)
#pragma unroll
            for (int m = 0; m < 4; ++m)
#pragma unroll
                for (int n = 0; n < 2; ++n) acc[a][b][m][n] = (f32x4){0.f, 0.f, 0.f, 0.f};
    bf16x8 At[4][2], B0[2][2], B1[2][2];
    const char* cA = (const char*)g.A + (size_t)cur.pm * tstep; const char* cB = (const char*)g.Bt + (size_t)cur.pn * tstep;
    S.a_ready(cur);
    if constexpr (SP2) {
        PG8_STAGE(PG8_SB(0, 0), cB, voffB); PG8_STAGE(PG8_SB(0, 1), cB + hstep, voffB); PG8_STAGE(PG8_SA(0, 0), cA, voffA); PG8_STAGE(PG8_SA(0, 1), cA + hstep, voffA);
        if (wr == 1) PG8_BAR;
        PG8_WAIT_V(2); PG8_BAR;
        PG8_STAGE(PG8_SB(1, 0), cB + kstep, voffB); PG8_STAGE(PG8_SA(1, 0), cA + kstep, voffA); PG8_STAGE(PG8_SB(1, 1), cB + hstep + kstep, voffB);
        PG8_WAIT_V(6); PG8_BAR;
    } else {
        PG8_STAGE(PG8_SB(0, 0), cB, voffB); PG8_STAGE(PG8_SA(0, 0), cA, voffA); PG8_STAGE(PG8_SB(0, 1), cB + hstep, voffB); PG8_STAGE(PG8_SA(0, 1), cA + hstep, voffA);
        if (wr == 1) PG8_BAR;
        PG8_WAIT_V(4); PG8_BAR;
        PG8_STAGE(PG8_SB(1, 0), cB + kstep, voffB); PG8_STAGE(PG8_SA(1, 0), cA + kstep, voffA); PG8_STAGE(PG8_SB(1, 1), cB + hstep + kstep, voffB);
        PG8_WAIT_V(6); PG8_BAR;
    }
    for (;;) {
        const bool has_next = S.next(ui + 1, nxt);
        const char* nA = has_next ? (const char*)g.A + (size_t)nxt.pm * tstep : cA; const char* nB = has_next ? (const char*)g.Bt + (size_t)nxt.pn * tstep : cB;
        for (int t = 0; t < nt; t += 2) {
            const bool last = (t == nt - 2);
            const char* a1 = cA + (size_t)(t + 1) * kstep;
            const char* a2 = last ? nA : cA + (size_t)(t + 2) * kstep; const char* b2 = last ? nB : cB + (size_t)(t + 2) * kstep;
            const char* a3 = a2 + kstep; const char* b3 = b2 + kstep;
            if (last && has_next) S.a_ready(nxt);
            if constexpr (SP2) {
            PG8_LDB(B0, 0, 0); PG8_LDB(B1, 0, 1); PG8_SCHED; PG8_LDA(At, 0, 0); PG8_STAGE(PG8_SA(1, 1), a1 + hstep, voffA);
            PG8_WAIT_V(8); PG8_WAIT_L(0); PG8_BAR; PG8_MMA(0, 0, At, B0); PG8_MMA(0, 1, At, B1); PG8_BAR; PG8_SCHED;
            PG8_LDA(At, 0, 1); PG8_STAGE(PG8_SB(0, 0), b2, voffB); PG8_STAGE(PG8_SB(0, 1), b2 + hstep, voffB); PG8_STAGE(PG8_SA(0, 0), a2, voffA);
            PG8_WAIT_V(8); PG8_WAIT_L(0); PG8_BAR; PG8_MMA(1, 0, At, B0); PG8_MMA(1, 1, At, B1); PG8_BAR; PG8_SCHED;
            PG8_LDB(B0, 1, 0); PG8_LDB(B1, 1, 1); PG8_SCHED; PG8_LDA(At, 1, 0); PG8_STAGE(PG8_SA(0, 1), a2 + hstep, voffA);
            PG8_WAIT_V(8); PG8_WAIT_L(0); PG8_BAR; PG8_MMA(0, 0, At, B0); PG8_MMA(0, 1, At, B1); PG8_BAR; PG8_SCHED;
            PG8_LDA(At, 1, 1); PG8_STAGE(PG8_SB(1, 0), b3, voffB); PG8_STAGE(PG8_SB(1, 1), b3 + hstep, voffB); PG8_STAGE(PG8_SA(1, 0), a3, voffA);
            PG8_WAIT_V(8); PG8_WAIT_L(0); PG8_BAR; PG8_MMA(1, 0, At, B0); PG8_MMA(1, 1, At, B1); PG8_BAR; PG8_SCHED;
            } else {
            PG8_LDB(B0, 0, 0); PG8_SCHED; PG8_LDA(At, 0, 0); PG8_STAGE(PG8_SA(1, 1), a1 + hstep, voffA);
            PG8_WAIT_L(8); PG8_BAR; PG8_WAIT_L(0); PG8_MMA(0, 0, At, B0); PG8_BAR; PG8_SCHED;
            PG8_LDB(B1, 0, 1); PG8_STAGE(PG8_SB(0, 0), b2, voffB);
            PG8_BAR; PG8_WAIT_L(0); PG8_MMA(0, 1, At, B1); PG8_BAR;
            PG8_LDA(At, 0, 1); PG8_STAGE(PG8_SA(0, 0), a2, voffA);
            PG8_BAR; PG8_WAIT_L(0); PG8_MMA(1, 0, At, B0); PG8_BAR; PG8_SCHED;
            PG8_STAGE(PG8_SB(0, 1), b2 + hstep, voffB);
            PG8_WAIT_V(6); PG8_BAR; PG8_MMA(1, 1, At, B1); PG8_BAR;
            PG8_LDB(B0, 1, 0); PG8_SCHED; PG8_LDA(At, 1, 0); PG8_STAGE(PG8_SA(0, 1), a2 + hstep, voffA);
            PG8_WAIT_L(8); PG8_BAR; PG8_WAIT_L(0); PG8_MMA(0, 0, At, B0); PG8_BAR; PG8_SCHED;
            PG8_LDB(B1, 1, 1); PG8_STAGE(PG8_SB(1, 0), b3, voffB);
            PG8_BAR; PG8_WAIT_L(0); PG8_MMA(0, 1, At, B1); PG8_BAR;
            PG8_LDA(At, 1, 1); PG8_STAGE(PG8_SA(1, 0), a3, voffA);
            PG8_BAR; PG8_WAIT_L(0); PG8_MMA(1, 0, At, B0); PG8_BAR; PG8_SCHED;
            PG8_STAGE(PG8_SB(1, 1), b3 + hstep, voffB);
            PG8_WAIT_V(6); PG8_BAR; PG8_MMA(1, 1, At, B1); PG8_BAR;
            }
        }
        if constexpr (ALIGN_EPI) { if (wr == 0) PG8_BAR; }
        if constexpr (!Epi::AFTER_DRAIN) { E(acc, cur, wr, wc, fr, fq); S.done(cur); }
        if (!has_next) break;
#pragma unroll
        for (int a = 0; a < 2; ++a)
#pragma unroll
            for (int b = 0; b < 2; ++b)
#pragma unroll
                for (int m = 0; m < 4; ++m)
#pragma unroll
                    for (int n = 0; n < 2; ++n) acc[a][b][m][n] = (f32x4){0.f, 0.f, 0.f, 0.f};
        cur = nxt; cA = nA; cB = nB; ++ui;
        if constexpr (ALIGN_EPI) { if (wr == 1) PG8_BAR; }
    }
    PG8_WAIT_V(0);
    if constexpr (!ALIGN_EPI) { if (wr == 0) PG8_BAR; }
    PG8_BAR;
    if constexpr (Epi::AFTER_DRAIN) { E.fused(acc, cur, wr, wc, fr, fq, lds, wid, lane); S.done(cur); }
#undef PG8_SA
#undef PG8_SB
#undef PG8_STAGE
#undef PG8_LDA
#undef PG8_LDB
#undef PG8_MMA
#undef PG8_WAIT_V
#undef PG8_WAIT_L
#undef PG8_BAR
#undef PG8_SCHED
}
}
#define GAS __attribute__((address_space(1)))
#define LAS __attribute__((address_space(3)))
typedef unsigned short bf16;
typedef unsigned v4u __attribute__((ext_vector_type(4)));
typedef float f32x4 __attribute__((ext_vector_type(4)));
typedef short bf16x8 __attribute__((ext_vector_type(8)));
typedef GAS unsigned gu32;
typedef GAS unsigned long long gu64;
#define RLX_AGENT __ATOMIC_RELAXED, __HIP_MEMORY_SCOPE_AGENT
#define LDS_WAIT() asm volatile("s_waitcnt lgkmcnt(0)" ::: "memory")
#define VM_WAIT() asm volatile("s_waitcnt vmcnt(0)" ::: "memory")
__device__ __forceinline__ unsigned long long rt() { return __builtin_amdgcn_s_memrealtime(); }
__device__ __forceinline__ unsigned f2bf(float f) { unsigned u = __builtin_bit_cast(unsigned, f); return (u + 0x7fffu + ((u >> 16) & 1u)) >> 16; }
__device__ __forceinline__ unsigned pk2(float lo, float hi) { return f2bf(lo) | (f2bf(hi) << 16); }

#define XB_TMO      128
#define XB_XCNT(j)  (256  + 64 * (j))
#define XB_XSUB(j)  (1280 + 64 * (j))
#define XB_XGEN(j)  (2304 + 64 * (j))
#define XB_TOP      3328
#define XB_TOPGEN   3392
#define XCD_BAR_WORDS 3456
#define XB_SPIN_CAP (1u << 18)

__device__ __forceinline__ unsigned xb_ld(unsigned* p)              { return __hip_atomic_load(p, __ATOMIC_RELAXED, __HIP_MEMORY_SCOPE_AGENT); }
__device__ __forceinline__ unsigned xb_add(unsigned* p, unsigned v) { return __hip_atomic_fetch_add(p, v, __ATOMIC_RELAXED, __HIP_MEMORY_SCOPE_AGENT); }
__device__ __forceinline__ unsigned xb_xcc_id() { return (unsigned)__builtin_amdgcn_s_getreg((3 << 11) | 20) & 0xFu; }
#define XB_SPIN(cond, bar) do { unsigned _sp = 0; while (cond) { __builtin_amdgcn_s_sleep(1); \
    if ((++_sp & 255u) == 0u) { if (xb_ld(&(bar)[XB_TMO])) break; if (_sp > XB_SPIN_CAP) { atomicAdd(&(bar)[XB_TMO], 1u); break; } } } } while (0)

struct XcdBarrier {
    unsigned* bar; unsigned x;
    volatile LAS unsigned* st;
};

__device__ __forceinline__ XcdBarrier xcd_barrier_post(unsigned* bar, volatile LAS unsigned* st) {
    XcdBarrier b; b.bar = bar; b.x = xb_xcc_id(); b.st = st;
    if (threadIdx.x == 0) (void)xb_add(&bar[XB_XCNT(b.x)], 1u);
    return b;
}
__device__ __forceinline__ void xcd_barrier_complete(unsigned* bar, unsigned x, unsigned& nloc, unsigned& nx) {
    const unsigned G = gridDim.x * gridDim.y * gridDim.z;
    unsigned sum, cnt, mine, sp = 0u;
    for (;;) {
        sum = 0u; cnt = 0u; mine = 0u;
#pragma unroll
        for (unsigned j = 0; j < 16; ++j) { const unsigned c = xb_ld(&bar[XB_XCNT(j)]); sum += c; cnt += (c > 0u) ? 1u : 0u; mine = (j == x) ? c : mine; }
        if (sum == G) break;
        __builtin_amdgcn_s_sleep(1);
        if ((++sp & 255u) == 0u) { if (xb_ld(&bar[XB_TMO])) break; if (sp > XB_SPIN_CAP) { atomicAdd(&bar[XB_TMO], 1u); break; } }
    }
    nloc = mine > 0u ? mine : 1u; nx = cnt > 0u ? cnt : 1u;
}

__device__ __forceinline__ void xcd_barrier(const XcdBarrier& b) {
    asm volatile("s_waitcnt vmcnt(0)" ::: "memory");
    __syncthreads();
    if (threadIdx.x == 0) {
        unsigned* bar = b.bar;
        __builtin_amdgcn_s_waitcnt(0);
        unsigned nloc = b.st[0], nx = b.st[1];
        if (nloc == 0u) { xcd_barrier_complete(bar, b.x, nloc, nx); b.st[0] = nloc; b.st[1] = nx; }
        const unsigned old = xb_add(&bar[XB_XSUB(b.x)], 1u);
        const unsigned gen = old / nloc;
        if (old + 1u == (gen + 1u) * nloc) {
            __builtin_amdgcn_fence(__ATOMIC_RELEASE, "agent");
            asm volatile("s_waitcnt vmcnt(0)" ::: "memory");
            const unsigned og = xb_add(&bar[XB_TOP], 1u);
            const unsigned tg = og / nx;
            if (og + 1u == (tg + 1u) * nx) xb_add(&bar[XB_TOPGEN], 1u);
            else XB_SPIN(xb_ld(&bar[XB_TOPGEN]) == tg, bar);
            __builtin_amdgcn_fence(__ATOMIC_ACQUIRE, "agent");
            xb_add(&bar[XB_XGEN(b.x)], 1u);
            asm volatile("s_waitcnt vmcnt(0)" ::: "memory");
        } else {
            XB_SPIN(xb_ld(&bar[XB_XGEN(b.x)]) == gen, bar);
            __builtin_amdgcn_fence(__ATOMIC_ACQUIRE, "agent");
            asm volatile("s_waitcnt vmcnt(0)" ::: "memory");
        }
    }
    __syncthreads();
}

#ifndef MK_PER_PHASE
#define MK_PER_PHASE 0
#endif
constexpr int NWAVES = 8;
constexpr int DM = 1024, NB = 8, SEQ = 2048, M = NB * SEQ, DEPTH = 4, DFF = 2816, NMEM = 256;
constexpr int INW = 6560;
constexpr int NRA = 5376;
constexpr int NWIN = 8448;
constexpr float EPS = 1e-6f;
constexpr float LOG2E = 1.4426950408889634f;
constexpr size_t MiB = 1u << 20;
constexpr size_t WS_CTL = 0, CTL_BYTES = 1 * MiB;
constexpr size_t WS_TAB = 1 * MiB;
constexpr size_t WS_W = 9 * MiB;
constexpr size_t W_13A = 0, W_2A = 11 * MiB, W_IN = 16 * MiB + 512 * 1024, W_BR = 33 * MiB, W_OUT = 36 * MiB, W_CQ = 38 * MiB, W_CO = 40 * MiB, W_13B = 42 * MiB, W_2B = 53 * MiB;
constexpr size_t WS_XB = 73 * MiB;
constexpr size_t WS_CK = 105 * MiB, WS_CVT = 121 * MiB;
constexpr size_t WS_KVC = 137 * MiB;
constexpr size_t WS_YBR = 171 * MiB;
constexpr size_t WS_RA = 219 * MiB;
constexpr size_t WS_ACT = WS_RA, WS_Z = WS_RA, WS_CQ = WS_RA, WS_CO = WS_RA + 32 * MiB, WS_Y = WS_RA + 96 * MiB;
constexpr size_t WS_PREP = 387 * MiB;
constexpr size_t P_RQ = 0, P_RK = 8 * MiB, P_RKDT = 16 * MiB, P_RVT = 24 * MiB, P_MQ = 40 * MiB, P_MK = 64 * MiB, P_MVT = 88 * MiB, P_DQ = 104 * MiB, P_DK = 120 * MiB, P_DVT = 136 * MiB;
constexpr size_t WS_G = WS_PREP + 40 * MiB;
constexpr size_t WS_T_WKV = WS_PREP, WS_T_MEMN = WS_PREP + 16 * MiB;
constexpr size_t WS_END = 539 * MiB;
constexpr int CW_BAR = 4096, CW_WQ = 16384, CW_LAM = 36000;

constexpr int RING_BYTES = 131072, LDSCTL_OFF = RING_BYTES, MISC_OFF = LDSCTL_OFF + 320, LDS_BYTES = 147456;

typedef short s16x4 __attribute__((ext_vector_type(4)));
typedef unsigned u32x2 __attribute__((ext_vector_type(2)));

struct Args {
    const float* in[22]; float* out; unsigned char* ws;
    float inv_freq[56]; float lam_init[4]; float log2g[4];
    int ph_lo, ph_hi;
};

struct Frame {
    LAS unsigned char* lds; volatile LAS unsigned* MISC; unsigned* ctl;
    int tid, lane, wave, G, gw, NGW;
    unsigned char* ws;
};

__device__ __forceinline__ float wave_sum(float v) {
#pragma unroll
    for (int o = 1; o < 64; o <<= 1) v += __shfl_xor(v, o);
    return v;
}
__device__ __forceinline__ float bflo(unsigned w) { return __uint_as_float(w << 16); }
__device__ __forceinline__ float bfhi(unsigned w) { return __uint_as_float(w & 0xffff0000u); }
__device__ __forceinline__ float bf1(bf16 h) { return __uint_as_float((unsigned)h << 16); }
__device__ __forceinline__ unsigned cvtpk(float lo, float hi) { return pg8::cvt_pk_bf16(lo, hi); }
__device__ __forceinline__ unsigned wq_next(unsigned* ctr, int lane) { unsigned v = 0; if (lane == 0) v = atomicAdd(ctr, 1u); return (unsigned)__builtin_amdgcn_readfirstlane((int)v); }

template <class CMap>
__device__ __forceinline__ void conv_item(const float* W, int ldw, int K, bf16* Bt, int k0, int n0, float scale, const CMap& cmap, LAS float* scr, int lane) {
    const int src = cmap(n0 + (lane & 31));
#pragma unroll 8
    for (int i = 0; i < 32; ++i) { const int kk = 2 * i + (lane >> 5); scr[kk * 33 + (lane & 31)] = src >= 0 ? W[(size_t)(k0 + kk) * ldw + src] * scale : 0.f; }
    LDS_WAIT(); asm volatile("" ::: "memory");
    const int c = lane & 7;
#pragma unroll
    for (int j = 0; j < 4; ++j) { const int n = (lane >> 3) + 8 * j; const LAS float* s = scr + (8 * c) * 33 + n;
        v4u o; o.x = cvtpk(s[0 * 33], s[1 * 33]); o.y = cvtpk(s[2 * 33], s[3 * 33]); o.z = cvtpk(s[4 * 33], s[5 * 33]); o.w = cvtpk(s[6 * 33], s[7 * 33]);
        *(v4u*)(Bt + (size_t)(n0 + n) * K + k0 + 8 * c) = o; }
    LDS_WAIT(); asm volatile("" ::: "memory");
}
struct MapId { __device__ int operator()(int n) const { return n; } };
struct MapSwiglu { __device__ int operator()(int n) const { const int j = n & 7, g = n >> 3; return j < 4 ? 4 * g + j : DFF + 4 * g + (j - 4); } };
struct MapWin {
    __device__ int operator()(int n) const {
        if (n < 1792) return n;
        if (n < 2048) { const int o = n - 1792; return o < 160 ? 1792 + o : -1; }
        if (n < 3584) return 1952 + (n - 2048);
        if (n < NRA) return -2;
        return 3488 + (n - NRA);
    }
};
__device__ __forceinline__ void fold_item(const float* win, int c0, int R, const float* g, const float* wb, int ldb, bf16* Bt  , int n0, int k0, LAS float* scr, int lane) {
    for (int i = 0; i < 16; ++i) for (int rr = lane * 4; rr < R; rr += 256) *(LAS f32x4*)(scr + i * 256 + rr) = *(const f32x4*)(win + (size_t)(k0 + i) * INW + c0 + rr);
    LDS_WAIT(); asm volatile("" ::: "memory");
    float acc[16];
#pragma unroll
    for (int i = 0; i < 16; ++i) acc[i] = 0.f;
    for (int r = 0; r < R; r += 4) {
        const f32x4 gv = *(const f32x4*)(g + r);
        const float a0 = gv[0] * wb[(size_t)(r + 0) * ldb + n0 + lane], a1 = gv[1] * wb[(size_t)(r + 1) * ldb + n0 + lane], a2 = gv[2] * wb[(size_t)(r + 2) * ldb + n0 + lane], a3 = gv[3] * wb[(size_t)(r + 3) * ldb + n0 + lane];
#pragma unroll
        for (int i = 0; i < 16; ++i) { const f32x4 w = *(const LAS f32x4*)(scr + i * 256 + r); acc[i] += (w[0] * a0 + w[1] * a1) + (w[2] * a2 + w[3] * a3); }
    }
    LDS_WAIT(); asm volatile("" ::: "memory");
    v4u o0, o1;
    o0.x = cvtpk(acc[0], acc[1]); o0.y = cvtpk(acc[2], acc[3]); o0.z = cvtpk(acc[4], acc[5]); o0.w = cvtpk(acc[6], acc[7]);
    o1.x = cvtpk(acc[8], acc[9]); o1.y = cvtpk(acc[10], acc[11]); o1.z = cvtpk(acc[12], acc[13]); o1.w = cvtpk(acc[14], acc[15]);
    bf16* p = Bt + (size_t)(n0 + lane) * DM + k0; *(v4u*)p = o0; *(v4u*)(p + 8) = o1;
}
__device__ __forceinline__ void wconv_layer(Frame& F, const Args& a, int l) {
    LAS float* scr = (LAS float*)(F.lds + F.wave * 16384);
    unsigned char* wb = F.ws + WS_W;
    const float* w13a = a.in[4] + (size_t)l * DM * 2 * DFF; const float* w2a = a.in[5] + (size_t)l * DFF * DM;
    const float* win = a.in[7] + (size_t)l * DM * INW;
    const float* wbr = a.in[13] + (size_t)l * 3 * 512 * DM; const float* wout = a.in[14] + (size_t)l * DM * DM;
    const float* cwq = a.in[16] + (size_t)l * DM * DM; const float* cwo = a.in[18] + (size_t)l * DM * DM;
    const float* w13b = a.in[20] + (size_t)l * DM * 2 * DFF; const float* w2b = a.in[21] + (size_t)l * DFF * DM;
    constexpr int I_13 = 16 * 176, I_2 = 44 * 32, I_IN = 16 * 264, I_BR = 8 * 32, I_SQ = 16 * 32;
    constexpr int I_FQ = 12 * 64, I_FKV = 16 * 64;
    constexpr int NIT = 2 * I_13 + 2 * I_2 + I_IN + 3 * I_BR + 3 * I_SQ + I_FQ + I_FKV;
    for (int it = F.gw; it < NIT; it += F.NGW) {
        int r = it;
        if (r < I_FQ) { fold_item(win, 1536, 256, a.in[8] + l * 256, a.in[10] + (size_t)l * 256 * 768, 768, (bf16*)(wb + W_IN) + (size_t)3584 * DM, (r % 12) * 64, (r / 12) * 16, scr, F.lane); continue; } r -= I_FQ;
        if (r < I_FKV) { fold_item(win, 1792, 128, a.in[9] + l * 128, a.in[11] + (size_t)l * 128 * 1024, 1024, (bf16*)(wb + W_IN) + (size_t)4352 * DM, (r % 16) * 64, (r / 16) * 16, scr, F.lane); continue; } r -= I_FKV;
        if (r < I_13) { conv_item(w13a, 2 * DFF, DM, (bf16*)(wb + W_13A), (r / 176) * 64, (r % 176) * 32, 1.f, MapSwiglu(), scr, F.lane); continue; } r -= I_13;
        if (r < I_13) { conv_item(w13b, 2 * DFF, DM, (bf16*)(wb + W_13B), (r / 176) * 64, (r % 176) * 32, 1.f, MapSwiglu(), scr, F.lane); continue; } r -= I_13;
        if (r < I_2) { conv_item(w2a, DM, DFF, (bf16*)(wb + W_2A), (r / 32) * 64, (r % 32) * 32, 1.f, MapId(), scr, F.lane); continue; } r -= I_2;
        if (r < I_2) { conv_item(w2b, DM, DFF, (bf16*)(wb + W_2B), (r / 32) * 64, (r % 32) * 32, 1.f, MapId(), scr, F.lane); continue; } r -= I_2;
        if (r < I_IN) { const int nb = r % 264, n0 = nb * 32; if (n0 >= 3584 && n0 < NRA) continue; conv_item(win, INW, DM, (bf16*)(wb + W_IN), (r / 264) * 64, n0, 1.f, MapWin(), scr, F.lane); continue; } r -= I_IN;
        if (r < 3 * I_BR) { const int b = r / I_BR, q = r % I_BR; conv_item(wbr + (size_t)b * 512 * DM, DM, 512, (bf16*)(wb + W_BR) + (size_t)b * DM * 512, (q / 32) * 64, (q % 32) * 32, 1.f, MapId(), scr, F.lane); continue; } r -= 3 * I_BR;
        if (r < I_SQ) { conv_item(wout, DM, DM, (bf16*)(wb + W_OUT), (r / 32) * 64, (r % 32) * 32, 1.f, MapId(), scr, F.lane); continue; } r -= I_SQ;
        if (r < I_SQ) { conv_item(cwq, DM, DM, (bf16*)(wb + W_CQ), (r / 32) * 64, (r % 32) * 32, 0.0625f * LOG2E, MapId(), scr, F.lane); continue; } r -= I_SQ;
        conv_item(cwo, DM, DM, (bf16*)(wb + W_CO), (r / 32) * 64, (r % 32) * 32, 1.f, MapId(), scr, F.lane);
    }
}

__device__ __forceinline__ void ew_phase(Frame& F, const float* xin, const float* y, const float* gpost, float scale, const float* gpre, float* xout, bf16* xb) {
    for (int row = F.gw; row < M; row += F.NGW) {
        const f32x4* xr = (const f32x4*)(xin + (size_t)row * DM) + F.lane;
        f32x4 xv[4];
#pragma unroll
        for (int j = 0; j < 4; ++j) xv[j] = xr[64 * j];
        if (y) {
            const f32x4* yr = (const f32x4*)(y + (size_t)row * DM) + F.lane; f32x4 yv[4]; float s = 0.f;
#pragma unroll
            for (int j = 0; j < 4; ++j) { yv[j] = yr[64 * j]; s += (yv[j].x * yv[j].x + yv[j].y * yv[j].y) + (yv[j].z * yv[j].z + yv[j].w * yv[j].w); }
            const float rs = scale * rsqrtf(wave_sum(s) * (1.f / DM) + EPS);
#pragma unroll
            for (int j = 0; j < 4; ++j) { const f32x4 g = ((const f32x4*)gpost)[F.lane + 64 * j]; xv[j] = xv[j] + yv[j] * g * rs; }
        }
        f32x4* xo = (f32x4*)(xout + (size_t)row * DM) + F.lane;
#pragma unroll
        for (int j = 0; j < 4; ++j) xo[64 * j] = xv[j];
        if (gpre) {
            float s = 0.f;
#pragma unroll
            for (int j = 0; j < 4; ++j) s += (xv[j].x * xv[j].x + xv[j].y * xv[j].y) + (xv[j].z * xv[j].z + xv[j].w * xv[j].w);
            const float rs = rsqrtf(wave_sum(s) * (1.f / DM) + EPS);
            u32x2* o8 = (u32x2*)(xb + (size_t)row * DM) + F.lane;
#pragma unroll
            for (int j = 0; j < 4; ++j) { const f32x4 g = ((const f32x4*)gpre)[F.lane + 64 * j]; const f32x4 v = xv[j] * g * rs; u32x2 w; w.x = cvtpk(v.x, v.y); w.y = cvtpk(v.z, v.w); o8[64 * j] = w; }
        }
    }
}

__device__ __forceinline__ void init_phase(Frame& F, const Args& a) {
    if (F.gw < DEPTH) { const int l = F.gw; const float* lp = a.in[12] + (size_t)l * 256;
        const float s01 = wave_sum(lp[F.lane] * lp[64 + F.lane]), s23 = wave_sum(lp[128 + F.lane] * lp[192 + F.lane]);
        if (F.lane == 0) ((float*)(F.ctl + CW_LAM))[l] = __expf(s01) - __expf(s23) + a.lam_init[l]; }
    float* tab = (float*)(F.ws + WS_TAB); const int* pos = (const int*)a.in[2];
    for (int e = blockIdx.x * 512 + F.tid; e < M * 56; e += F.G * 512) {
        const int t = e / 56, i = e % 56; const double ang = (double)pos[t] * (double)a.inv_freq[i];
        const double rev = ang * 0.15915494309189535; const float fr = (float)(rev - __builtin_rint(rev));
        tab[2 * e] = __builtin_amdgcn_cosf(fr); tab[2 * e + 1] = __builtin_amdgcn_sinf(fr);
    }
    const float* mem = a.in[1]; bf16* memn = (bf16*)(F.ws + WS_T_MEMN);
    for (int row = F.gw; row < NB * NMEM; row += F.NGW) {
        const f32x4* xr = (const f32x4*)(mem + (size_t)row * DM) + F.lane; f32x4 xv[4]; float s = 0.f;
#pragma unroll
        for (int j = 0; j < 4; ++j) { xv[j] = xr[64 * j]; s += (xv[j].x * xv[j].x + xv[j].y * xv[j].y) + (xv[j].z * xv[j].z + xv[j].w * xv[j].w); }
        const float rs = rsqrtf(wave_sum(s) * (1.f / DM) + EPS);
        for (int l = 0; l < DEPTH; ++l) { const float* g2 = a.in[15] + (size_t)(l * 3 + 2) * DM; u32x2* o8 = (u32x2*)(memn + ((size_t)l * 2048 + row) * DM) + F.lane;
#pragma unroll
            for (int j = 0; j < 4; ++j) { const f32x4 g = ((const f32x4*)g2)[F.lane + 64 * j]; const f32x4 v = xv[j] * g * rs; u32x2 w; w.x = cvtpk(v.x, v.y); w.y = cvtpk(v.z, v.w); o8[64 * j] = w; } }
    }
    LAS float* scr = (LAS float*)(F.lds + F.wave * 16384);
    for (int it = F.gw; it < DEPTH * 16 * 64; it += F.NGW) { const int l = it / 1024, r = it % 1024;
        conv_item(a.in[17] + (size_t)l * DM * 2048, 2048, DM, (bf16*)(F.ws + WS_T_WKV) + (size_t)l * 2048 * DM, (r / 64) * 64, (r % 64) * 32, 1.f, MapId(), scr, F.lane); }
}

__device__ __forceinline__ void ld8(const bf16* p, float (&v)[8]) {
    const v4u w = *(const v4u*)p; v[0] = bflo(w.x); v[1] = bfhi(w.x); v[2] = bflo(w.y); v[3] = bfhi(w.y); v[4] = bflo(w.z); v[5] = bfhi(w.z); v[6] = bflo(w.w); v[7] = bfhi(w.w);
}
__device__ __forceinline__ void st8(bf16* p, const float (&v)[8]) { v4u w; w.x = cvtpk(v[0], v[1]); w.y = cvtpk(v[2], v[3]); w.z = cvtpk(v[4], v[5]); w.w = cvtpk(v[6], v[7]); *(v4u*)p = w; }
__device__ __forceinline__ void rope8(const bf16* vec, int H, int p0, const float* tab, float scale, float (&out)[8]) {
    const int i0 = p0 < H ? p0 : p0 - H; float x1[8], x2[8]; ld8(vec + i0, x1); ld8(vec + H + i0, x2);
    const f32x4* tp = (const f32x4*)(tab + 2 * i0); const f32x4 t0 = tp[0], t1 = tp[1], t2 = tp[2], t3 = tp[3];
    const float c[8] = {t0.x, t0.z, t1.x, t1.z, t2.x, t2.z, t3.x, t3.z}, s[8] = {t0.y, t0.w, t1.y, t1.w, t2.y, t2.w, t3.y, t3.w};
    if (p0 < H) {
#pragma unroll
        for (int i = 0; i < 8; ++i) out[i] = (x1[i] * c[i] - x2[i] * s[i]) * scale;
    } else {
#pragma unroll
        for (int i = 0; i < 8; ++i) out[i] = (x2[i] * c[i] + x1[i] * s[i]) * scale;
    }
}
__device__ __forceinline__ void prep_phase(Frame& F, const Args& a) {
    const bf16* R = (const bf16*)(F.ws + WS_RA); const float* tab = (const float*)(F.ws + WS_TAB); unsigned char* P = F.ws + WS_PREP;
    LAS float* rq = (LAS float*)F.lds; LAS float* rkv = rq + 64;
    for (int ch = blockIdx.x; ch < M / 64; ch += F.G) {
        const int tok0 = ch * 64, b = tok0 / SEQ, s0 = tok0 % SEQ;
        for (int i = 0; i < 8; ++i) { const int tl = F.wave * 8 + i; const bf16* r = R + (size_t)(tok0 + tl) * NRA;
            const u32x2 w = *(const u32x2*)(r + 1536 + F.lane * 4); float s = bflo(w.x) * bflo(w.x) + bfhi(w.x) * bfhi(w.x) + bflo(w.y) * bflo(w.y) + bfhi(w.y) * bfhi(w.y);
            s = wave_sum(s); const unsigned w2 = *(const unsigned*)(r + 1792 + F.lane * 2); float s2 = bflo(w2) * bflo(w2) + bfhi(w2) * bfhi(w2); s2 = wave_sum(s2);
            if (F.lane == 0) { rq[tl] = rsqrtf(s * (1.f / 256.f) + EPS); rkv[tl] = rsqrtf(s2 * (1.f / 128.f) + EPS); } }
        __syncthreads();
        for (int i = F.tid; i < 64 * 32; i += 512) { const int tl = i >> 5, g = i & 31, tok = tok0 + tl, h = g >> 3, p0 = (g & 7) * 8; const bf16* r = R + (size_t)tok * NRA; float o[8];
            rope8(r + h * 64, 32, p0, tab + (size_t)tok * 112, 0.125f, o); st8((bf16*)(P + P_RQ) + (size_t)tok * 256 + g * 8, o);
            rope8(r + 256 + h * 64, 32, p0, tab + (size_t)tok * 112, 1.f, o); st8((bf16*)(P + P_RK) + (size_t)tok * 256 + g * 8, o); }
        for (int i = F.tid; i < 64 * 96; i += 512) { const int tl = i / 96, g = i % 96, tok = tok0 + tl, h = g / 12, j0 = (g % 12) * 8; const bf16* r = R + (size_t)tok * NRA; float o[8];
            const float sq = rq[tl] * (0.10206207261596577f * LOG2E), skv = rkv[tl];
            if (j0 < 64) { ld8(r + 3584 + h * 96 + j0, o);
#pragma unroll
                for (int e = 0; e < 8; ++e) o[e] *= sq; }
            else rope8(r + 3584 + h * 96 + 64, 16, j0 - 64, tab + (size_t)tok * 112 + 64, sq, o);
            st8((bf16*)(P + P_MQ) + (size_t)tok * 768 + g * 8, o);
            if (j0 < 64) { ld8(r + 4352 + h * 128 + j0, o);
#pragma unroll
                for (int e = 0; e < 8; ++e) o[e] *= skv; }
            else rope8(r + 1792 + 128, 16, j0 - 64, tab + (size_t)tok * 112 + 64, 1.f, o);
            st8((bf16*)(P + P_MK) + (size_t)tok * 768 + g * 8, o); }
        for (int i = F.tid; i < 64 * 64; i += 512) { const int tl = i >> 6, g = i & 63, tok = tok0 + tl, hm = g >> 3, d0 = (g & 7) * 8; const bf16* r = R + (size_t)tok * NRA; float o[8];
            if (d0 < 16) rope8(r + 2048 + hm * 64, 8, d0, tab + (size_t)tok * 112 + 96, 0.125f * LOG2E, o);
            else { ld8(r + 2048 + hm * 64 + d0, o);
#pragma unroll
                for (int e = 0; e < 8; ++e) o[e] *= 0.125f * LOG2E; }
            st8((bf16*)(P + P_DQ) + (size_t)tok * 512 + g * 8, o);
            if (d0 < 16) rope8(r + 2560 + hm * 64, 8, d0, tab + (size_t)tok * 112 + 96, 1.f, o); else ld8(r + 2560 + hm * 64 + d0, o);
            st8((bf16*)(P + P_DK) + (size_t)tok * 512 + g * 8, o); }
        { const int tok = tok0 + F.lane; const bf16* r = R + (size_t)tok * NRA; const float* tb = tab + (size_t)tok * 112; const float rkv_l = rkv[F.lane];
            for (int gi = F.wave; gi < 224; gi += 8) { const int c = gi * 8; float o[8]; bf16* dst;
                if (c < 256) { const int h = c >> 6, d0 = c & 63; rope8(r + 256 + h * 64, 32, d0, tb, exp2f(a.log2g[h] * (float)(63 - F.lane)), o);
                    dst = (bf16*)(P + P_RKDT) + ((size_t)(b * 4 + h) * 64 + d0) * SEQ; }
                else if (c < 768) { const int cc = c - 256; ld8(r + 512 + cc, o); dst = (bf16*)(P + P_RVT) + ((size_t)b * 512 + cc) * SEQ; }
                else if (c < 1280) { const int cc = c - 768, h = cc >> 6, e0 = cc & 63; ld8(r + 4352 + h * 128 + 64 + e0, o);
#pragma unroll
                    for (int e = 0; e < 8; ++e) o[e] *= rkv_l;
                    dst = (bf16*)(P + P_MVT) + ((size_t)b * 512 + cc) * SEQ; }
                else { const int cc = c - 1280; ld8(r + 3072 + cc, o); dst = (bf16*)(P + P_DVT) + ((size_t)b * 512 + cc) * SEQ; }
                dst += s0 + F.lane;
#pragma unroll
                for (int e = 0; e < 8; e += 2) { const unsigned w = cvtpk(o[e], o[e + 1]); dst[(size_t)e * SEQ] = (bf16)(w & 0xffffu); dst[(size_t)(e + 1) * SEQ] = (bf16)(w >> 16); }
            } }
        __syncthreads();
    }
}

template <int DK, int DV, int NQG>
__device__ __forceinline__ void attn_core(const bf16* __restrict__ Qp, int ldq, const bf16* __restrict__ Kp, int ldk, const bf16* __restrict__ VTp, int ldv, int nkeys,
                                          f32x4 (&o)[NQG][DV / 16], float (&linv)[NQG], int lane) {
    constexpr int NKS = DK / 32, NDV = DV / 16;
    const int fr = lane & 15, fq = lane >> 4;
    bf16x8 qf[NQG][NKS];
#pragma unroll
    for (int g = 0; g < NQG; ++g)
#pragma unroll
        for (int ks = 0; ks < NKS; ++ks) qf[g][ks] = *(const bf16x8*)(Qp + (size_t)(g * 16 + fr) * ldq + ks * 32 + fq * 8);
    float mrow[NQG], lrow[NQG];
#pragma unroll
    for (int g = 0; g < NQG; ++g) { mrow[g] = -1e30f; lrow[g] = 0.f;
#pragma unroll
        for (int d = 0; d < NDV; ++d) o[g][d] = (f32x4){0.f, 0.f, 0.f, 0.f}; }
    const bf16* kbase = Kp + (size_t)fr * ldk + fq * 8;
    const bf16* vbase = VTp + (size_t)fr * ldv + fq * 4;
    for (int kt = 0; kt < nkeys; kt += 64) {
        f32x4 s[NQG][4];
#pragma unroll
        for (int kb = 0; kb < 4; ++kb) {
            bf16x8 kf[NKS];
#pragma unroll
            for (int ks = 0; ks < NKS; ++ks) kf[ks] = *(const bf16x8*)(kbase + (size_t)(kt + kb * 16) * ldk + ks * 32);
#pragma unroll
            for (int g = 0; g < NQG; ++g) { f32x4 c = (f32x4){0.f, 0.f, 0.f, 0.f};
#pragma unroll
                for (int ks = 0; ks < NKS; ++ks) c = __builtin_amdgcn_mfma_f32_16x16x32_bf16(kf[ks], qf[g][ks], c, 0, 0, 0);
                s[g][kb] = c; }
        }
        bf16x8 pb[NQG][2];
#pragma unroll
        for (int g = 0; g < NQG; ++g) {
            float mx = fmaxf(fmaxf(s[g][0][0], s[g][0][1]), fmaxf(s[g][0][2], s[g][0][3]));
#pragma unroll
            for (int kb = 1; kb < 4; ++kb) mx = fmaxf(mx, fmaxf(fmaxf(s[g][kb][0], s[g][kb][1]), fmaxf(s[g][kb][2], s[g][kb][3])));
            mx = fmaxf(mx, __shfl_xor(mx, 16)); mx = fmaxf(mx, __shfl_xor(mx, 32));
            const float mn = fmaxf(mrow[g], mx), alpha = __builtin_amdgcn_exp2f(mrow[g] - mn); mrow[g] = mn;
            float ps = 0.f; float p[4][4];
#pragma unroll
            for (int kb = 0; kb < 4; ++kb)
#pragma unroll
                for (int j = 0; j < 4; ++j) { p[kb][j] = __builtin_amdgcn_exp2f(s[g][kb][j] - mn); ps += p[kb][j]; }
            lrow[g] = lrow[g] * alpha + ps;
#pragma unroll
            for (int d = 0; d < NDV; ++d) o[g][d] = o[g][d] * alpha;
#pragma unroll
            for (int kg = 0; kg < 2; ++kg) { v4u w; w.x = cvtpk(p[2 * kg][0], p[2 * kg][1]); w.y = cvtpk(p[2 * kg][2], p[2 * kg][3]); w.z = cvtpk(p[2 * kg + 1][0], p[2 * kg + 1][1]); w.w = cvtpk(p[2 * kg + 1][2], p[2 * kg + 1][3]);
                pb[g][kg] = __builtin_bit_cast(bf16x8, w); }
        }
#pragma unroll
        for (int kg = 0; kg < 2; ++kg)
#pragma unroll
            for (int d = 0; d < NDV; ++d) {
                const bf16* vp = vbase + (size_t)(d * 16) * ldv + kt + kg * 32;
                const u32x2 lo = *(const u32x2*)vp, hi = *(const u32x2*)(vp + 16);
                v4u w; w.x = lo.x; w.y = lo.y; w.z = hi.x; w.w = hi.y; const bf16x8 vf = __builtin_bit_cast(bf16x8, w);
#pragma unroll
                for (int g = 0; g < NQG; ++g) o[g][d] = __builtin_amdgcn_mfma_f32_16x16x32_bf16(vf, pb[g][kg], o[g][d], 0, 0, 0);
            }
    }
#pragma unroll
    for (int g = 0; g < NQG; ++g) { float l = lrow[g]; l += __shfl_xor(l, 16); l += __shfl_xor(l, 32); linv[g] = 1.0f / l; }
}

template <int DK, int DV, int NQG, bool DBUF>
__device__ __forceinline__ void attn_block(LAS unsigned char* lds, const bf16* __restrict__ Qp, int ldq, const bf16* __restrict__ Kp, int ldk, const bf16* __restrict__ VTp, int ldv,
                                           int ntiles, int my_tiles, f32x4 (&o)[NQG][DV / 16], float (&linv)[NQG], int tid, int lane) {
    constexpr int NKS = DK / 32, NDV = DV / 16, CK = DK / 8, KROW = (DK + 8) * 2, KBYTES = 64 * KROW, VROW = 144, VBYTES = DV * VROW, BUF = KBYTES + VBYTES;
    constexpr int NKC = (64 * CK + 511) / 512, NVC = (DV * 8) / 512;
    const int fr = lane & 15, fq = lane >> 4;
    bf16x8 qf[NQG][NKS];
#pragma unroll
    for (int g = 0; g < NQG; ++g)
#pragma unroll
        for (int ks = 0; ks < NKS; ++ks) qf[g][ks] = *(const bf16x8*)(Qp + (size_t)(g * 16 + fr) * ldq + ks * 32 + fq * 8);
    float mrow[NQG], lrow[NQG];
#pragma unroll
    for (int g = 0; g < NQG; ++g) { mrow[g] = -1e30f; lrow[g] = 0.f;
#pragma unroll
        for (int d = 0; d < NDV; ++d) o[g][d] = (f32x4){0.f, 0.f, 0.f, 0.f}; }
    v4u kst[NKC], vst[NVC];
    auto load_tile = [&](int t) {
#pragma unroll
        for (int i = 0; i < NKC; ++i) { const int c = tid + 512 * i; if ((64 * CK) % 512 == 0 || c < 64 * CK) { const int row = c / CK, cc = c % CK; kst[i] = *(const v4u*)(Kp + (size_t)(t * 64 + row) * ldk + cc * 8); } }
#pragma unroll
        for (int i = 0; i < NVC; ++i) { const int c = tid + 512 * i, row = c >> 3, j = c & 7; vst[i] = *(const v4u*)(VTp + (size_t)row * ldv + t * 64 + j * 8); }
    };
    auto store_tile = [&](int buf) {
        LAS unsigned char* kb_ = lds + buf * BUF; LAS unsigned char* vb_ = kb_ + KBYTES;
#pragma unroll
        for (int i = 0; i < NKC; ++i) { const int c = tid + 512 * i; if ((64 * CK) % 512 == 0 || c < 64 * CK) { const int row = c / CK, cc = c % CK; *(LAS v4u*)(kb_ + row * KROW + cc * 16) = kst[i]; } }
#pragma unroll
        for (int i = 0; i < NVC; ++i) { const int c = tid + 512 * i, row = c >> 3, j = c & 7; const int qa = 2 * j, qb_ = 2 * j + 1;
            const int pa = (qa >> 3) * 8 + (qa & 3) * 2 + ((qa >> 2) & 1), pb_ = (qb_ >> 3) * 8 + (qb_ & 3) * 2 + ((qb_ >> 2) & 1);
            u32x2 lo; lo.x = vst[i].x; lo.y = vst[i].y; u32x2 hi; hi.x = vst[i].z; hi.y = vst[i].w;
            *(LAS u32x2*)(vb_ + row * VROW + pa * 8) = lo; *(LAS u32x2*)(vb_ + row * VROW + pb_ * 8) = hi; }
    };
    load_tile(0); store_tile(0);
    __syncthreads();
#pragma unroll 1
    for (int t = 0; t < ntiles; ++t) {
        const int cur = DBUF ? (t & 1) : 0;
        if (t + 1 < ntiles) load_tile(t + 1);
        if (t < my_tiles) {
            const LAS unsigned char* kb_ = lds + cur * BUF + fr * KROW + fq * 16; const LAS unsigned char* vb_ = lds + cur * BUF + KBYTES + fr * VROW + fq * 16;
            f32x4 s[NQG][4];
#pragma unroll
            for (int kb = 0; kb < 4; ++kb) {
                bf16x8 kf[NKS];
#pragma unroll
                for (int ks = 0; ks < NKS; ++ks) kf[ks] = *(const LAS bf16x8*)(kb_ + kb * 16 * KROW + ks * 64);
#pragma unroll
                for (int g = 0; g < NQG; ++g) { f32x4 c = (f32x4){0.f, 0.f, 0.f, 0.f};
#pragma unroll
                    for (int ks = 0; ks < NKS; ++ks) c = __builtin_amdgcn_mfma_f32_16x16x32_bf16(kf[ks], qf[g][ks], c, 0, 0, 0);
                    s[g][kb] = c; }
            }
            bf16x8 pb[NQG][2];
#pragma unroll
            for (int g = 0; g < NQG; ++g) {
                float mx = fmaxf(fmaxf(s[g][0][0], s[g][0][1]), fmaxf(s[g][0][2], s[g][0][3]));
#pragma unroll
                for (int kb = 1; kb < 4; ++kb) mx = fmaxf(mx, fmaxf(fmaxf(s[g][kb][0], s[g][kb][1]), fmaxf(s[g][kb][2], s[g][kb][3])));
                mx = fmaxf(mx, __shfl_xor(mx, 16)); mx = fmaxf(mx, __shfl_xor(mx, 32));
                const float mn = fmaxf(mrow[g], mx), alpha = __builtin_amdgcn_exp2f(mrow[g] - mn); mrow[g] = mn;
                float ps = 0.f; float p[4][4];
#pragma unroll
                for (int kb = 0; kb < 4; ++kb)
#pragma unroll
                    for (int j = 0; j < 4; ++j) { p[kb][j] = __builtin_amdgcn_exp2f(s[g][kb][j] - mn); ps += p[kb][j]; }
                lrow[g] = lrow[g] * alpha + ps;
#pragma unroll
                for (int d = 0; d < NDV; ++d) o[g][d] = o[g][d] * alpha;
#pragma unroll
                for (int kg = 0; kg < 2; ++kg) { v4u w; w.x = cvtpk(p[2 * kg][0], p[2 * kg][1]); w.y = cvtpk(p[2 * kg][2], p[2 * kg][3]); w.z = cvtpk(p[2 * kg + 1][0], p[2 * kg + 1][1]); w.w = cvtpk(p[2 * kg + 1][2], p[2 * kg + 1][3]);
                    pb[g][kg] = __builtin_bit_cast(bf16x8, w); }
            }
#pragma unroll
            for (int kg = 0; kg < 2; ++kg)
#pragma unroll
                for (int d = 0; d < NDV; ++d) {
                    const bf16x8 vf = *(const LAS bf16x8*)(vb_ + d * 16 * VROW + kg * 64);
#pragma unroll
                    for (int g = 0; g < NQG; ++g) o[g][d] = __builtin_amdgcn_mfma_f32_16x16x32_bf16(vf, pb[g][kg], o[g][d], 0, 0, 0);
                }
        }
        if (DBUF) { if (t + 1 < ntiles) store_tile((t + 1) & 1); __syncthreads(); }
        else { __syncthreads(); if (t + 1 < ntiles) store_tile(0); __syncthreads(); }
    }
#pragma unroll
    for (int g = 0; g < NQG; ++g) { float l = lrow[g]; l += __shfl_xor(l, 16); l += __shfl_xor(l, 32); linv[g] = 1.0f / l; }
}
__device__ __forceinline__ void mla_block(Frame& F, int b, int h, int qb8) {
    int lane_ = F.lane; asm volatile("" : "+v"(lane_));
    unsigned char* P = F.ws + WS_PREP; const int q0 = b * SEQ + qb8 * 256 + F.wave * 32;
    f32x4 o[2][4]; float linv[2];
    attn_block<96, 64, 2, true>(F.lds, (const bf16*)(P + P_MQ) + (size_t)q0 * 768 + h * 96, 768, (const bf16*)(P + P_MK) + (size_t)b * SEQ * 768 + h * 96, 768,
                                (const bf16*)(P + P_MVT) + (size_t)(b * 8 + h) * 64 * SEQ, SEQ, qb8 * 4 + 4, qb8 * 4 + (F.wave >> 1) + 1, o, linv, F.wave * 64 + lane_, lane_);
    const int fr = lane_ & 15, fq = lane_ >> 4; bf16* Y = (bf16*)(F.ws + WS_YBR) + (size_t)1 * M * 512;
#pragma unroll
    for (int g = 0; g < 2; ++g)
#pragma unroll
        for (int d = 0; d < 4; ++d) { const f32x4 v = o[g][d] * linv[g]; u32x2 w; w.x = cvtpk(v[0], v[1]); w.y = cvtpk(v[2], v[3]);
            *(u32x2*)(Y + (size_t)(q0 + g * 16 + fr) * 512 + h * 64 + d * 16 + fq * 4) = w; }
}
__device__ __forceinline__ void diff_block(Frame& F, const Args& a, int l, int b, int h, int qb8) {
    int lane_ = F.lane; asm volatile("" : "+v"(lane_));
    unsigned char* P = F.ws + WS_PREP; const int q0 = b * SEQ + qb8 * 256 + F.wave * 32;
    const float lam_init = a.lam_init[l], lam = ((const float*)(F.ctl + CW_LAM))[l];
    LAS unsigned* stash = (LAS unsigned*)(F.lds + 57344 + F.wave * 8192) + lane_;
    f32x4 o[2][8]; float linv[2];
    for (int map = 0; map < 2; ++map) {
        attn_block<64, 128, 2, true>(F.lds, (const bf16*)(P + P_DQ) + (size_t)q0 * 512 + (h * 2 + map) * 64, 512, (const bf16*)(P + P_DK) + (size_t)b * SEQ * 512 + (h * 2 + map) * 64, 512,
                                     (const bf16*)(P + P_DVT) + (size_t)(b * 4 + h) * 128 * SEQ, SEQ, qb8 * 4 + 4, qb8 * 4 + (F.wave >> 1) + 1, o, linv, F.wave * 64 + lane_, lane_);
        if (map == 0) {
#pragma unroll
            for (int g = 0; g < 2; ++g)
#pragma unroll
                for (int d = 0; d < 8; ++d) { stash[((g * 8 + d) * 2 + 0) * 64] = cvtpk(o[g][d][0] * linv[g], o[g][d][1] * linv[g]); stash[((g * 8 + d) * 2 + 1) * 64] = cvtpk(o[g][d][2] * linv[g], o[g][d][3] * linv[g]); }
        }
    }
    const int fr = lane_ & 15, fq = lane_ >> 4; bf16* Y = (bf16*)(F.ws + WS_YBR) + (size_t)2 * M * 512;
#pragma unroll
    for (int g = 0; g < 2; ++g) { float ss = 0.f;
#pragma unroll
        for (int d = 0; d < 8; ++d) { const unsigned w0 = stash[((g * 8 + d) * 2 + 0) * 64], w1 = stash[((g * 8 + d) * 2 + 1) * 64];
            f32x4 v; v[0] = bflo(w0) - lam * o[g][d][0] * linv[g]; v[1] = bfhi(w0) - lam * o[g][d][1] * linv[g]; v[2] = bflo(w1) - lam * o[g][d][2] * linv[g]; v[3] = bfhi(w1) - lam * o[g][d][3] * linv[g];
            o[g][d] = v; ss += (v[0] * v[0] + v[1] * v[1]) + (v[2] * v[2] + v[3] * v[3]); }
        ss += __shfl_xor(ss, 16); ss += __shfl_xor(ss, 32);
        const float rs = rsqrtf(ss * (1.f / 128.f) + EPS) * (1.f - lam_init);
#pragma unroll
        for (int d = 0; d < 8; ++d) { const f32x4 v = o[g][d] * rs; u32x2 w; w.x = cvtpk(v[0], v[1]); w.y = cvtpk(v[2], v[3]);
            *(u32x2*)(Y + (size_t)(q0 + g * 16 + fr) * 512 + h * 128 + d * 16 + fq * 4) = w; } }
}
__device__ __forceinline__ void cross_block(Frame& F, int l, int b, int h, int qb, int half) {
    int lane_ = F.lane; asm volatile("" : "+v"(lane_));
    const int q0 = b * SEQ + qb * 128 + F.wave * 16;
    f32x4 o[1][8]; float linv[1];
    attn_block<256, 128, 1, true>(F.lds, (const bf16*)(F.ws + WS_CQ) + (size_t)q0 * DM + h * 256, DM, (const bf16*)(F.ws + WS_CK) + ((size_t)l * 2048 + b * 256) * DM + h * 256, DM,
                                  (const bf16*)(F.ws + WS_CVT) + (size_t)l * 2048 * DM + ((size_t)(b * 4 + h) * 256 + half * 128) * 256, 256, 4, 4, o, linv, F.wave * 64 + lane_, lane_);
    const int fr = lane_ & 15, fq = lane_ >> 4; bf16* O = (bf16*)(F.ws + WS_CO);
#pragma unroll
    for (int d = 0; d < 8; ++d) { const f32x4 v = o[0][d] * linv[0]; u32x2 w; w.x = cvtpk(v[0], v[1]); w.y = cvtpk(v[2], v[3]);
        *(u32x2*)(O + (size_t)(q0 + fr) * DM + h * 256 + half * 128 + d * 16 + fq * 4) = w; }
}
__device__ __forceinline__ unsigned wq_next_block(Frame& F, unsigned* ctr) {
    volatile LAS unsigned* uq = (volatile LAS unsigned*)(F.lds + LDSCTL_OFF + 64);
    __syncthreads();
    if (F.tid == 0) *uq = atomicAdd(ctr, 1u);
    __syncthreads();
    return (unsigned)__builtin_amdgcn_readfirstlane((int)*uq);
}
__device__ __forceinline__ void mla_unit(Frame& F, int b, int h, int qb) {
    int lane_ = F.lane; asm volatile("" : "+v"(lane_));
    unsigned char* P = F.ws + WS_PREP; const int q0 = b * SEQ + qb * 32, nkeys = ((qb >> 1) + 1) * 64;
    f32x4 o[2][4]; float linv[2];
    attn_core<96, 64, 2>((const bf16*)(P + P_MQ) + (size_t)q0 * 768 + h * 96, 768, (const bf16*)(P + P_MK) + (size_t)b * SEQ * 768 + h * 96, 768,
                         (const bf16*)(P + P_MVT) + (size_t)(b * 8 + h) * 64 * SEQ, SEQ, nkeys, o, linv, lane_);
    const int fr = lane_ & 15, fq = lane_ >> 4; bf16* Y = (bf16*)(F.ws + WS_YBR) + (size_t)1 * M * 512;
#pragma unroll
    for (int g = 0; g < 2; ++g)
#pragma unroll
        for (int d = 0; d < 4; ++d) { const f32x4 v = o[g][d] * linv[g]; u32x2 w; w.x = cvtpk(v[0], v[1]); w.y = cvtpk(v[2], v[3]);
            *(u32x2*)(Y + (size_t)(q0 + g * 16 + fr) * 512 + h * 64 + d * 16 + fq * 4) = w; }
}
__device__ __forceinline__ void diff_unit(Frame& F, const Args& a, int l, int b, int h, int qb) {
    int lane_ = F.lane; asm volatile("" : "+v"(lane_));
    unsigned char* P = F.ws + WS_PREP; const int q0 = b * SEQ + qb * 32, nkeys = ((qb >> 1) + 1) * 64;
    const float lam_init = a.lam_init[l], lam = ((const float*)(F.ctl + CW_LAM))[l];
    LAS float* stash = (LAS float*)(F.lds + F.wave * 16384) + lane_;
    f32x4 o[2][8]; float linv[2];
    for (int map = 0; map < 2; ++map) {
        attn_core<64, 128, 2>((const bf16*)(P + P_DQ) + (size_t)q0 * 512 + (h * 2 + map) * 64, 512, (const bf16*)(P + P_DK) + (size_t)b * SEQ * 512 + (h * 2 + map) * 64, 512,
                              (const bf16*)(P + P_DVT) + (size_t)(b * 4 + h) * 128 * SEQ, SEQ, nkeys, o, linv, lane_);
        if (map == 0) {
#pragma unroll
            for (int g = 0; g < 2; ++g)
#pragma unroll
                for (int d = 0; d < 8; ++d)
#pragma unroll
                    for (int j = 0; j < 4; ++j) stash[((g * 8 + d) * 4 + j) * 64] = o[g][d][j] * linv[g];
        }
    }
    const int fr = lane_ & 15, fq = lane_ >> 4; bf16* Y = (bf16*)(F.ws + WS_YBR) + (size_t)2 * M * 512;
#pragma unroll
    for (int g = 0; g < 2; ++g) { float ss = 0.f;
#pragma unroll
        for (int d = 0; d < 8; ++d)
#pragma unroll
            for (int j = 0; j < 4; ++j) { const float v = stash[((g * 8 + d) * 4 + j) * 64] - lam * o[g][d][j] * linv[g]; o[g][d][j] = v; ss += v * v; }
        ss += __shfl_xor(ss, 16); ss += __shfl_xor(ss, 32);
        const float rs = rsqrtf(ss * (1.f / 128.f) + EPS) * (1.f - lam_init);
#pragma unroll
        for (int d = 0; d < 8; ++d) { const f32x4 v = o[g][d] * rs; u32x2 w; w.x = cvtpk(v[0], v[1]); w.y = cvtpk(v[2], v[3]);
            *(u32x2*)(Y + (size_t)(q0 + g * 16 + fr) * 512 + h * 128 + d * 16 + fq * 4) = w; } }
}
__device__ __forceinline__ void cross_unit(Frame& F, int l, int b, int h, int qb, int half) {
    int lane_ = F.lane; asm volatile("" : "+v"(lane_));
    const int q0 = b * SEQ + qb * 16;
    f32x4 o[1][8]; float linv[1];
    attn_core<256, 128, 1>((const bf16*)(F.ws + WS_CQ) + (size_t)q0 * DM + h * 256, DM, (const bf16*)(F.ws + WS_CK) + ((size_t)l * 2048 + b * 256) * DM + h * 256, DM,
                           (const bf16*)(F.ws + WS_CVT) + (size_t)l * 2048 * DM + ((size_t)(b * 4 + h) * 256 + half * 128) * 256, 256, 256, o, linv, lane_);
    const int fr = lane_ & 15, fq = lane_ >> 4; bf16* O = (bf16*)(F.ws + WS_CO);
#pragma unroll
    for (int d = 0; d < 8; ++d) { const f32x4 v = o[0][d] * linv[0]; u32x2 w; w.x = cvtpk(v[0], v[1]); w.y = cvtpk(v[2], v[3]);
        *(u32x2*)(O + (size_t)(q0 + fr) * DM + h * 256 + half * 128 + d * 16 + fq * 4) = w; }
}
__device__ __forceinline__ void ret_kv_unit(Frame& F, int b, int c, int h) {
    int lane_ = F.lane; asm volatile("" : "+v"(lane_));
    unsigned char* P = F.ws + WS_PREP; const int fr = lane_ & 15, fq = lane_ >> 4;
    const bf16* kd = (const bf16*)(P + P_RKDT) + (size_t)(b * 4 + h) * 64 * SEQ + c * 64;
    const bf16* vt = (const bf16*)(P + P_RVT) + (size_t)(b * 4 + h) * 128 * SEQ + c * 64;
    float* out = (float*)(F.ws + WS_KVC) + (size_t)((b * 32 + c) * 4 + h) * 8192;
    bf16x8 af[4][2];
#pragma unroll
    for (int db = 0; db < 4; ++db)
#pragma unroll
        for (int ks = 0; ks < 2; ++ks) af[db][ks] = *(const bf16x8*)(kd + (size_t)(db * 16 + fr) * SEQ + ks * 32 + fq * 8);
#pragma unroll
    for (int eb = 0; eb < 8; ++eb) { bf16x8 bfv[2];
#pragma unroll
        for (int ks = 0; ks < 2; ++ks) bfv[ks] = *(const bf16x8*)(vt + (size_t)(eb * 16 + fr) * SEQ + ks * 32 + fq * 8);
#pragma unroll
        for (int db = 0; db < 4; ++db) { f32x4 cacc = (f32x4){0.f, 0.f, 0.f, 0.f};
#pragma unroll
            for (int ks = 0; ks < 2; ++ks) cacc = __builtin_amdgcn_mfma_f32_16x16x32_bf16(af[db][ks], bfv[ks], cacc, 0, 0, 0);
            *(f32x4*)(out + (size_t)(eb * 16 + fr) * 64 + db * 16 + fq * 4) = cacc; } }
}
__device__ __forceinline__ void ret_scan_phase(Frame& F, const Args& a) {
    float* kvc = (float*)(F.ws + WS_KVC);
    for (int e = blockIdx.x * 512 + F.tid; e < NB * 4 * 8192; e += F.G * 512) {
        const int b = e / (4 * 8192), h = (e / 8192) & 3, idx = e & 8191; const float dec = exp2f(a.log2g[h] * 64.f);
        float* p = kvc + (size_t)(b * 32 * 4 + h) * 8192 + idx;
        float kv[32];
#pragma unroll
        for (int c = 0; c < 32; ++c) kv[c] = p[(size_t)c * 4 * 8192];
        float st = 0.f;
#pragma unroll
        for (int c = 0; c < 32; ++c) { p[(size_t)c * 4 * 8192] = st; st = st * dec + kv[c]; }
    }
}
__device__ __forceinline__ void ret_out_unit(Frame& F, const Args& a, int b, int c, int h, int half) {
    int lane_ = F.lane; asm volatile("" : "+v"(lane_));
    unsigned char* P = F.ws + WS_PREP; const int fr = lane_ & 15, fq = lane_ >> 4; const int t0 = b * SEQ + c * 64; const float l2g = a.log2g[h];
    const bf16* Qp = (const bf16*)(P + P_RQ) + (size_t)(t0 + half * 32) * 256 + h * 64;
    const bf16* Kp = (const bf16*)(P + P_RK) + (size_t)t0 * 256 + h * 64;
    const bf16* vt = (const bf16*)(P + P_RVT) + (size_t)(b * 4 + h) * 128 * SEQ + c * 64;
    const float* st = (const float*)(F.ws + WS_KVC) + (size_t)((b * 32 + c) * 4 + h) * 8192;
    bf16x8 qf[2][2];
#pragma unroll
    for (int g = 0; g < 2; ++g)
#pragma unroll
        for (int ks = 0; ks < 2; ++ks) qf[g][ks] = *(const bf16x8*)(Qp + (size_t)(g * 16 + fr) * 256 + ks * 32 + fq * 8);
    bf16x8 pb[2][2];
    {
        f32x4 s[2][4];
#pragma unroll
        for (int kb = 0; kb < 4; ++kb) { bf16x8 kf[2];
#pragma unroll
            for (int ks = 0; ks < 2; ++ks) kf[ks] = *(const bf16x8*)(Kp + (size_t)(kb * 16 + fr) * 256 + ks * 32 + fq * 8);
#pragma unroll
            for (int g = 0; g < 2; ++g) { f32x4 cacc = (f32x4){0.f, 0.f, 0.f, 0.f};
#pragma unroll
                for (int ks = 0; ks < 2; ++ks) cacc = __builtin_amdgcn_mfma_f32_16x16x32_bf16(kf[ks], qf[g][ks], cacc, 0, 0, 0);
                s[g][kb] = cacc; } }
#pragma unroll
        for (int g = 0; g < 2; ++g) { const int n = half * 32 + g * 16 + fr; float p[4][4];
#pragma unroll
            for (int kb = 0; kb < 4; ++kb)
#pragma unroll
                for (int j = 0; j < 4; ++j) { const int mk = kb * 16 + fq * 4 + j; const int dd = n > mk ? n - mk : mk - n; p[kb][j] = s[g][kb][j] * exp2f(l2g * (float)dd); }
#pragma unroll
            for (int kg = 0; kg < 2; ++kg) { v4u w; w.x = cvtpk(p[2 * kg][0], p[2 * kg][1]); w.y = cvtpk(p[2 * kg][2], p[2 * kg][3]); w.z = cvtpk(p[2 * kg + 1][0], p[2 * kg + 1][1]); w.w = cvtpk(p[2 * kg + 1][2], p[2 * kg + 1][3]);
                pb[g][kg] = __builtin_bit_cast(bf16x8, w); } }
    }
    f32x4 o[2][8];
#pragma unroll
    for (int d = 0; d < 8; ++d) {
        f32x4 x[2] = {(f32x4){0.f, 0.f, 0.f, 0.f}, (f32x4){0.f, 0.f, 0.f, 0.f}};
#pragma unroll
        for (int ks = 0; ks < 2; ++ks) { const float* sp = st + (size_t)(d * 16 + fr) * 64 + ks * 32 + fq * 8; const f32x4 s0 = *(const f32x4*)sp, s1 = *(const f32x4*)(sp + 4);
            v4u w; w.x = cvtpk(s0[0], s0[1]); w.y = cvtpk(s0[2], s0[3]); w.z = cvtpk(s1[0], s1[1]); w.w = cvtpk(s1[2], s1[3]); const bf16x8 sf = __builtin_bit_cast(bf16x8, w);
#pragma unroll
            for (int g = 0; g < 2; ++g) x[g] = __builtin_amdgcn_mfma_f32_16x16x32_bf16(sf, qf[g][ks], x[g], 0, 0, 0); }
#pragma unroll
        for (int g = 0; g < 2; ++g) { const int n = half * 32 + g * 16 + fr; o[g][d] = x[g] * exp2f(l2g * (float)(n + 1)); }
#pragma unroll
        for (int kg = 0; kg < 2; ++kg) { const bf16* vp = vt + (size_t)(d * 16 + fr) * SEQ + kg * 32 + fq * 4; const u32x2 lo = *(const u32x2*)vp, hi = *(const u32x2*)(vp + 16);
            v4u w; w.x = lo.x; w.y = lo.y; w.z = hi.x; w.w = hi.y; const bf16x8 vf = __builtin_bit_cast(bf16x8, w);
#pragma unroll
            for (int g = 0; g < 2; ++g) o[g][d] = __builtin_amdgcn_mfma_f32_16x16x32_bf16(vf, pb[g][kg], o[g][d], 0, 0, 0); }
    }
    const bf16* R = (const bf16*)(F.ws + WS_RA); bf16* Y = (bf16*)(F.ws + WS_YBR);
#pragma unroll
    for (int g = 0; g < 2; ++g) { float ss = 0.f;
#pragma unroll
        for (int d = 0; d < 8; ++d) ss += (o[g][d][0] * o[g][d][0] + o[g][d][1] * o[g][d][1]) + (o[g][d][2] * o[g][d][2] + o[g][d][3] * o[g][d][3]);
        ss += __shfl_xor(ss, 16); ss += __shfl_xor(ss, 32);
        const float rs = rsqrtf(ss * (1.f / 128.f) + EPS); const size_t tok = (size_t)(t0 + half * 32 + g * 16 + fr);
#pragma unroll
        for (int d = 0; d < 8; ++d) { const u32x2 gw = *(const u32x2*)(R + tok * NRA + 1024 + h * 128 + d * 16 + fq * 4);
            const float g0 = bflo(gw.x), g1 = bfhi(gw.x), g2 = bflo(gw.y), g3 = bfhi(gw.y);
            const float v0 = o[g][d][0] * rs * g0 * pg8::sigmoidf_(g0), v1 = o[g][d][1] * rs * g1 * pg8::sigmoidf_(g1), v2 = o[g][d][2] * rs * g2 * pg8::sigmoidf_(g2), v3 = o[g][d][3] * rs * g3 * pg8::sigmoidf_(g3);
            u32x2 w; w.x = cvtpk(v0, v1); w.y = cvtpk(v2, v3); *(u32x2*)(Y + tok * 512 + h * 128 + d * 16 + fq * 4) = w; } }
}

#ifndef MK_DUP_MASK
#define MK_DUP_MASK 0
#endif
#ifndef MK_LAST_PHASE
#define MK_LAST_PHASE (1 + 18 * 4)
#endif
constexpr int PH_PER_LAYER = 18, N_PHASES = MK_LAST_PHASE;
template <int MODE>
__device__ __forceinline__ void run_static_gemm(Frame& F, const bf16* A, const bf16* Bt, int N, int K, void* O, const void* aux, int ldc) {
    pg8::Gemm g{A, Bt, M, N, K}; pg8::StaticOrder S; S.init(M, N, F.G, (int)blockIdx.x);
    pg8::EpiX<MODE> E{O, aux, ldc};
    pg8::gemm_phase<pg8::EpiX<MODE>, pg8::StaticOrder, true, true>(F.lds, g, S, E, F.wave);
}

__global__ void __launch_bounds__(NWAVES * 64, 2) mk_fwd(Args a_) {
    extern __shared__ __attribute__((aligned(16))) unsigned char lds_raw[];
    {
        LAS unsigned char* l0 = (LAS unsigned char*)lds_raw;
        for (int u = threadIdx.x; u < (LDS_BYTES - LDSCTL_OFF) / 4; u += NWAVES * 64) ((LAS unsigned*)(l0 + LDSCTL_OFF))[u] = 0u;
        __syncthreads();
    }
    if (a_.ph_lo == 0 && blockIdx.x == 0) { unsigned* c0 = (unsigned*)(a_.ws + WS_CTL); for (int u = threadIdx.x; u < 32768; u += NWAVES * 64) __hip_atomic_store(c0 + u, 0u, __ATOMIC_RELAXED, __HIP_MEMORY_SCOPE_AGENT); __threadfence(); }
#if !MK_PER_PHASE
    cg::this_grid().sync();
    XcdBarrier bar = xcd_barrier_post((unsigned*)(a_.ws + WS_CTL) + CW_BAR, (volatile LAS unsigned*)((LAS unsigned char*)lds_raw + MISC_OFF) + 8);
#endif
    const int ph_lo = a_.ph_lo, ph_hi = a_.ph_hi; const int wave0 = __builtin_amdgcn_readfirstlane((int)threadIdx.x >> 6);
    int rep_ = 0;
    for (int ph = ph_lo; ph < ph_hi; ++ph) {
        const __attribute__((address_space(4))) Args* ap4 = (const __attribute__((address_space(4))) Args*)__builtin_amdgcn_kernarg_segment_ptr();
        asm volatile("" : "+s"(ap4));
        const Args& a = *(const Args*)ap4;
        Frame F;
        F.lds = (LAS unsigned char*)lds_raw; F.MISC = (volatile LAS unsigned*)(F.lds + MISC_OFF);
        { int w_ = wave0; asm volatile("" : "+s"(w_)); int l_ = (int)__builtin_amdgcn_mbcnt_hi(~0u, __builtin_amdgcn_mbcnt_lo(~0u, 0u)); asm volatile("" : "+v"(l_)); F.wave = w_; F.lane = l_; F.tid = w_ * 64 + l_; }
        F.G = gridDim.x; F.gw = blockIdx.x * NWAVES + F.wave; F.NGW = F.G * NWAVES; F.ws = a.ws; F.ctl = (unsigned*)(a.ws + WS_CTL);
        unsigned char* ws = a.ws; unsigned char* wb = ws + WS_W; float* x = a.out;
        bf16* XB = (bf16*)(ws + WS_XB);
        if (ph == 0) {
            init_phase(F, a);
            ew_phase(F, a.in[0], nullptr, nullptr, 0.f, a.in[3], x, XB);
            wconv_layer(F, a, 0);
        } else {
            const int l = (ph - 1) / PH_PER_LAYER, j = (ph - 1) % PH_PER_LAYER;
            const float* n_ffn1 = a.in[3] + (size_t)l * 2 * DM; const float* n_mix = a.in[6] + (size_t)l * 2 * DM; const float* n_cross = a.in[15] + (size_t)l * 3 * DM; const float* n_ffn2 = a.in[19] + (size_t)l * 2 * DM;
            if (j == 0 || j == 15) {
                if (j == 0 && l == 0) {
                    pg8::Gemm g{(const bf16*)(ws + WS_T_MEMN), (const bf16*)(ws + WS_T_WKV), 8192, 8192, DM}; pg8::CkvOrder S{F.G, (int)blockIdx.x};
                    pg8::EpiX<5> E{(void*)(ws + WS_CK), (const void*)(ws + WS_CVT), DM};
                    pg8::gemm_phase<pg8::EpiX<5>, pg8::CkvOrder, true, true>(F.lds, g, S, E, F.wave);
                }
                run_static_gemm<1>(F, XB, (const bf16*)(wb + (j == 0 ? W_13A : W_13B)), 2 * DFF, DM, (void*)(ws + WS_ACT), nullptr, DFF);
            } else if (j == 1 || j == 16 || j == 9 || j == 13) {
                const bf16* A = (j == 1 || j == 16) ? (const bf16*)(ws + WS_ACT) : (j == 9 ? (const bf16*)(ws + WS_Z) : (const bf16*)(ws + WS_CO));
                const bf16* Bt = (const bf16*)(wb + (j == 1 ? W_2A : j == 16 ? W_2B : j == 9 ? W_OUT : W_CO));
                run_static_gemm<2>(F, A, Bt, DM, (j == 1 || j == 16) ? DFF : DM, (void*)(ws + WS_Y), nullptr, DM);
            } else if (j == 2 || j == 10 || j == 14 || j == 17) {
                const float* gpost = j == 2 ? n_ffn1 + DM : j == 10 ? n_mix + DM : j == 14 ? n_cross + DM : n_ffn2 + DM;
                const float* gpre = j == 2 ? n_mix : j == 10 ? n_cross : j == 14 ? n_ffn2 : (l + 1 < DEPTH ? a.in[3] + (size_t)(l + 1) * 2 * DM : nullptr);
                ew_phase(F, x, (const float*)(ws + WS_Y), gpost, rep_ ? 0.f : ((j == 2 || j == 17) ? 0.5f : 1.0f), gpre, x, XB);
                if (j == 17 && l + 1 < DEPTH) wconv_layer(F, a, l + 1);
            } else if (j == 3 || j == 11) {
                if (j == 3) run_static_gemm<0>(F, XB, (const bf16*)(wb + W_IN), NRA, DM, (void*)(ws + WS_RA), nullptr, NRA);
                else run_static_gemm<0>(F, XB, (const bf16*)(wb + W_CQ), DM, DM, (void*)(ws + WS_CQ), nullptr, DM);
            } else if (j == 4) {
                prep_phase(F, a);
            } else if (j == 5) {
                unsigned* ctr = F.ctl + CW_WQ + 64 * (l * 4 + 0) + 16 * rep_;
                for (;;) { const unsigned u = wq_next_block(F, ctr); if (u >= 256u + 512u + 128u) break;
                    if (u < 256u) { const int qb8 = 7 - (int)(u >> 5), bh = u & 31; diff_block(F, a, l, bh >> 2, bh & 3, qb8); }
                    else if (u < 768u) { const unsigned v = u - 256u; const int qb8 = 7 - (int)(v >> 6), bh = v & 63; mla_block(F, bh >> 3, bh & 7, qb8); }
                    else { const unsigned v = (u - 768u) * 8 + F.wave; ret_kv_unit(F, v >> 7, (v >> 2) & 31, v & 3); } }
            } else if (j == 6) {
                if (rep_ == 0) ret_scan_phase(F, a);
                run_static_gemm<3>(F, XB, (const bf16*)(wb + W_IN) + (size_t)NRA * DM, 3072, DM, (void*)(ws + WS_G), nullptr, 3072);
            } else if (j == 7) {
                unsigned* ctr = F.ctl + CW_WQ + 64 * (l * 4 + 1) + 16 * rep_;
                for (;;) { const unsigned u = wq_next(ctr, F.lane); if (u >= 2048u) break; ret_out_unit(F, a, u >> 8, (u >> 3) & 31, (u >> 1) & 3, u & 1); }
            } else if (j == 8) {
                pg8::Gemm g{(const bf16*)(ws + WS_YBR), (const bf16*)(wb + W_BR), 3 * M, 3 * DM, 512}; pg8::BranchOrder S{F.G, (int)blockIdx.x};
                pg8::EpiX<4> E{(void*)(ws + WS_Z), (const void*)(ws + WS_G), DM};
                pg8::gemm_phase<pg8::EpiX<4>, pg8::BranchOrder, true, true>(F.lds, g, S, E, F.wave);
            } else {
                unsigned* ctr = F.ctl + CW_WQ + 64 * (l * 4 + 2) + 16 * rep_;
                for (;;) { const unsigned u = wq_next_block(F, ctr); if (u >= 1024u) break; const int bh = u >> 5; cross_block(F, l, bh >> 2, bh & 3, (u >> 1) & 15, u & 1); }
            }
        }
#if !MK_PER_PHASE
        if (ph + 1 < ph_hi) { xcd_barrier(bar); if ((MK_DUP_MASK >> 19) & 1) xcd_barrier(bar); }
#endif
        if (MK_DUP_MASK != 0) { const int jj_ = ph == 0 ? 18 : (ph - 1) % PH_PER_LAYER; if (rep_ == 0 && ((MK_DUP_MASK >> jj_) & 1) && ph + 1 < ph_hi) { rep_ = 1; --ph; } else rep_ = 0; }
    }
}

extern "C" void kernel_launch(void* const* d_in, const int* in_sizes, int n_in, void* d_out, int out_size, void* d_ws, size_t ws_size, hipStream_t stream) {
    static int grid = 0;
    if (grid == 0) {
        if (n_in != 22 || out_size != M * DM || ws_size < WS_END) { fprintf(stderr, "kernel_launch: unexpected shapes (n_in %d, out %d, ws %zu)\n", n_in, out_size, ws_size); grid = -1; return; }
        int dev = 0, cus = 0;
        hipGetDevice(&dev); hipDeviceGetAttribute(&cus, hipDeviceAttributeMultiprocessorCount, dev);
        if (hipFuncSetAttribute((const void*)mk_fwd, hipFuncAttributeMaxDynamicSharedMemorySize, LDS_BYTES) != hipSuccess) { fprintf(stderr, "kernel_launch: hipFuncSetAttribute failed\n"); grid = -1; return; }
        int per_cu = 0;
        if (hipOccupancyMaxActiveBlocksPerMultiprocessor(&per_cu, (const void*)mk_fwd, NWAVES * 64, LDS_BYTES) != hipSuccess || per_cu < 1) { fprintf(stderr, "kernel_launch: occupancy query says %d\n", per_cu); (void)hipGetLastError(); }
        grid = cus;
    }
    if (grid < 0) return;
    hipMemsetAsync((char*)d_ws + WS_CTL, 0, CTL_BYTES, stream);
    Args a; memset(&a, 0, sizeof(a));
    for (int i = 0; i < 22; ++i) a.in[i] = (const float*)d_in[i];
    a.out = (float*)d_out; a.ws = (unsigned char*)d_ws;
    for (int i = 0; i < 32; ++i) a.inv_freq[i] = (float)(1.0 / pow(10000.0, (double)(2 * i) / 64.0));
    for (int i = 0; i < 16; ++i) a.inv_freq[32 + i] = (float)(1.0 / pow(500000.0, (double)(2 * i) / 32.0));
    for (int i = 0; i < 8; ++i) a.inv_freq[48 + i] = (float)(1.0 / pow(500000.0, (double)(2 * i) / 16.0));
    for (int l = 0; l < 4; ++l) { a.lam_init[l] = (float)(0.8 - 0.6 * exp(-0.3 * l)); a.log2g[l] = (float)log2(1.0 - pow(2.0, -5.0 - l)); }
#if MK_PER_PHASE
    for (int ph = 0; ph < N_PHASES; ++ph) { a.ph_lo = ph; a.ph_hi = ph + 1; hipLaunchKernelGGL(mk_fwd, dim3(grid), dim3(NWAVES * 64), LDS_BYTES, stream, a); }
#else
    a.ph_lo = 0; a.ph_hi = N_PHASES;
    void* args[] = {&a};
    hipError_t e = hipLaunchCooperativeKernel((const void*)mk_fwd, dim3(grid), dim3(NWAVES * 64), args, LDS_BYTES, stream);
    if (e != hipSuccess) fprintf(stderr, "cooperative launch failed: %s (grid %d)\n", hipGetErrorString(e), grid);
#endif
}
```
